# Optimizing an MI355X kernel written in HIP

```python
import jax, jax.numpy as jnp
from jax import lax
import numpy as np

D_MODEL = 1024
BATCH = 8
SEQ = 2048
DEPTH = 4

CHUNK = 64
N_A = DEPTH // 2
N_B = DEPTH - N_A
GM_BLOCK = 128
A_WIDTH = 2 * D_MODEL
A_GROUPS = 8
A_GROUP_CH = A_WIDTH // A_GROUPS
B_HEADS = 8
B_HEAD_DIM = D_MODEL // B_HEADS
B_WIDTH = B_HEADS * B_HEAD_DIM
Q_BLOCK = 128
PLE_DIM = 256
EPS = 1e-6

kernel_name = "yoco_gmlp_stickbreaking_trunk"


def rmsnorm(x, g):
    xf = x.astype(jnp.float32)
    y = xf * lax.rsqrt(jnp.mean(xf * xf, axis=-1, keepdims=True) + EPS)
    return (y * g.astype(jnp.float32)).astype(x.dtype)


def layernorm(x, g, b):
    xf = x.astype(jnp.float32)
    mu = jnp.mean(xf, axis=-1, keepdims=True)
    var = jnp.mean(jnp.square(xf - mu), axis=-1, keepdims=True)
    y = (xf - mu) * lax.rsqrt(var + EPS)
    return (y * g.astype(jnp.float32) + b.astype(jnp.float32)).astype(x.dtype)


def gmlp_mixer(hn, w_in, ln_g, ln_b, w_s, b_s, w_out):
    B, S, _ = hn.shape
    z = hn @ w_in
    u, v, gate = jnp.split(z, 3, axis=-1)
    u = jax.nn.gelu(u, approximate=False)
    v = layernorm(jax.nn.gelu(v, approximate=False), ln_g, ln_b)
    cid = jnp.arange(GM_BLOCK) // CHUNK
    mask = cid[None, :] <= cid[:, None]
    w = jnp.where(mask[None], w_s, jnp.zeros_like(w_s))
    vb = v.reshape(B, S // GM_BLOCK, GM_BLOCK, A_GROUPS, A_GROUP_CH)
    sv = jnp.einsum('gts,bnsgc->bntgc', w, vb) + b_s.T[None, None, :, :, None]
    sv = sv.reshape(B, S, A_WIDTH)
    return (u * sv * jax.nn.silu(gate)) @ w_out


def stick_breaking(q, k, v):
    S = q.shape[1]
    scale = 1.0 / np.sqrt(B_HEAD_DIM)
    outs = []
    for i in range(S // Q_BLOCK):
        q0 = i * Q_BLOCK
        k_end = q0 + Q_BLOCK
        qb = q[:, q0:k_end]
        kb = k[:, :k_end]
        vb = v[:, :k_end]
        z = jnp.einsum('bthd,bshd->bhts', qb, kb).astype(jnp.float32) * scale
        t_pos = q0 + jnp.arange(Q_BLOCK)
        s_pos = jnp.arange(k_end)
        causal = s_pos[None, :] < t_pos[:, None]
        log_beta = jnp.where(causal, jax.nn.log_sigmoid(z), -jnp.inf)
        log_1m = jnp.where(causal, jax.nn.log_sigmoid(-z), 0.0)
        suffix = lax.cumsum(log_1m, axis=3, reverse=True) - log_1m
        a = jnp.exp(log_beta + suffix).astype(vb.dtype)
        outs.append(jnp.einsum('bhts,bshd->bthd', a, vb))
    return jnp.concatenate(outs, axis=1)


def setup_inputs(seed: int = 0) -> dict:
    key = jax.random.key(seed)
    ks = jax.random.split(key, 20)
    f32 = jnp.float32
    nrm = lambda k, shape, s: jax.random.normal(k, shape, f32) * s
    D = D_MODEL
    return {
        "x": nrm(ks[0], (BATCH, SEQ, D), 1.0),
        "p": nrm(ks[1], (DEPTH, BATCH, SEQ, PLE_DIM), 1.0),
        "norm_g": 1.0 + nrm(ks[2], (DEPTH, D), 0.02),
        "a_w_in": nrm(ks[3], (N_A, D, 3 * A_WIDTH), D ** -0.5),
        "a_ln_g": 1.0 + nrm(ks[4], (N_A, A_WIDTH), 0.02),
        "a_ln_b": nrm(ks[5], (N_A, A_WIDTH), 0.02),
        "a_w_s": nrm(ks[6], (N_A, A_GROUPS, GM_BLOCK, GM_BLOCK), 0.5 * GM_BLOCK ** -0.5),
        "a_b_s": 1.0 + nrm(ks[7], (N_A, A_GROUPS, GM_BLOCK), 0.02),
        "a_w_out": nrm(ks[8], (N_A, A_WIDTH, D), A_WIDTH ** -0.5),
        "kv_norm_g": 1.0 + nrm(ks[9], (D,), 0.02),
        "w_kv": nrm(ks[10], (D, 2 * B_WIDTH), D ** -0.5),
        "b_w_in": nrm(ks[11], (N_B, D, 2 * B_WIDTH), D ** -0.5),
        "b_w_out": nrm(ks[12], (N_B, B_WIDTH, D), B_WIDTH ** -0.5),
        "ple_w": nrm(ks[13], (DEPTH, PLE_DIM, D), 0.5 * PLE_DIM ** -0.5),
        "ple_gate_w": nrm(ks[14], (DEPTH, D, D), D ** -0.5),
        "final_g": 1.0 + nrm(ks[15], (D,), 0.02),
    }


def reference(x, p, norm_g, a_w_in, a_ln_g, a_ln_b, a_w_s, a_b_s, a_w_out,
              kv_norm_g, w_kv, b_w_in, b_w_out, ple_w, ple_gate_w, final_g):
    B, S, _ = x.shape
    h = x
    k_sh = None
    v_sh = None
    for i in range(DEPTH):
        hn = rmsnorm(h, norm_g[i])
        if i < N_A:
            mix = gmlp_mixer(hn, a_w_in[i], a_ln_g[i], a_ln_b[i],
                             a_w_s[i], a_b_s[i], a_w_out[i])
        else:
            if k_sh is None:
                kv = rmsnorm(h, kv_norm_g) @ w_kv
                k_sh, v_sh = jnp.split(kv, 2, axis=-1)
                k_sh = k_sh.reshape(B, S, B_HEADS, B_HEAD_DIM)
                v_sh = v_sh.reshape(B, S, B_HEADS, B_HEAD_DIM)
            j = i - N_A
            qg = hn @ b_w_in[j]
            q, gate = jnp.split(qg, 2, axis=-1)
            q = q.reshape(B, S, B_HEADS, B_HEAD_DIM)
            o = stick_breaking(q, k_sh, v_sh).reshape(B, S, B_WIDTH)
            mix = (o * jax.nn.silu(gate)) @ b_w_out[j]
        h = h + mix
        h = h + jax.nn.sigmoid(h @ ple_gate_w[i]) * (p[i] @ ple_w[i])
    return rmsnorm(h, final_g)
```

```cpp
#include <hip/hip_runtime.h>
#include <hip/hip_cooperative_groups.h>
#include <cstdio>
#include <cstdint>

#define LAS __attribute__((address_space(3)))
#define GAS __attribute__((address_space(1)))
typedef unsigned short bf16_t;
typedef short bf16x8 __attribute__((ext_vector_type(8)));
typedef short s16x4 __attribute__((ext_vector_type(4)));
typedef float f32x4 __attribute__((ext_vector_type(4)));
typedef float f32x2 __attribute__((ext_vector_type(2)));
typedef float f32x16 __attribute__((ext_vector_type(16)));
typedef unsigned u32x4 __attribute__((ext_vector_type(4)));
typedef unsigned u32x2 __attribute__((ext_vector_type(2)));

#define DUP_ATTN 1
#define DUP_LITE 0
#define DUP_A1 1
#define DUP_KVQ 1
#define DUP_E 1
#define DUP_P0 1
#define DUP_BAR 1
#define DUP_MIX 1
#define DUP_MIXG 1
#define DUP_PLE 1
constexpr int D_MODEL = 1024, BATCH = 8, SEQ = 2048, DEPTH = 4, N_A = 2, A_WIDTH = 2048, A_GROUPS = 8, B_HEADS = 8, HEAD_DIM = 128, PLE_DIM = 256;
constexpr int M = BATCH * SEQ;
constexpr float EPS = 1e-6f;
constexpr float LOG2E = 1.4426950408889634f;
constexpr float QSCALE = 0.08838834764831845f * LOG2E;

constexpr size_t MiB = 1u << 20;
constexpr size_t WS_CTL = 0, CTL_ZERO_BYTES = 64 * 1024;
constexpr size_t WS_ROWSS = 1 * MiB;
constexpr size_t WS_LNST = 2 * MiB;
constexpr size_t WS_WIN = 6 * MiB;
constexpr size_t WS_WOUT = 30 * MiB;
constexpr size_t WS_WKVQ = 38 * MiB;
constexpr size_t WS_WQ3 = 46 * MiB;
constexpr size_t WS_WBO = 50 * MiB;
constexpr size_t WS_WG = 54 * MiB;
constexpr size_t WS_WP = 62 * MiB;
constexpr size_t WS_PB = 64 * MiB;
constexpr size_t WS_HB0 = 72 * MiB;
constexpr size_t WS_REG = 104 * MiB;
constexpr size_t WS_UG = WS_REG, WS_GV = WS_REG + 64 * MiB;
constexpr size_t WS_K = WS_REG, WS_V = WS_REG + 32 * MiB, WS_Q = WS_REG + 64 * MiB, WS_SG = WS_REG + 96 * MiB;
constexpr size_t WS_EA = WS_GV, WS_HB1A = WS_GV + 32 * MiB;
constexpr size_t WS_EB = WS_SG, WS_HB1B = WS_WIN;
constexpr size_t WS_END = 232 * MiB;

constexpr int RING_BYTES = 131072;
constexpr int LDSCTL_OFF = RING_BYTES, MISC_OFF = LDSCTL_OFF + 320;
constexpr int LDS_BYTES = 147456;
constexpr int NWAVES = 8;

namespace pg8 {
constexpr int BM = 256, BK = 64, HALF = 128, HTB = HALF * BK * 2, STAGE_BYTES = 8 * HTB, NXCD = 8, WGM = 8;
__host__ __device__ __forceinline__ int lds_byte(int r, int c) { const int st = (r >> 4) * 2 + (c >> 5), rr = r & 15, cc = c & 31, ob = rr * 64 + cc * 2; return st * 1024 + (ob ^ (((ob >> 9) & 1) << 5)); }
__host__ __device__ __forceinline__ void stage_rc(int b, int& R, int& C) { const int st = b / 1024, sb = b % 1024, swz = sb ^ (((sb >> 9) & 1) << 5); R = (st >> 1) * 16 + swz / 64; C = (st & 1) * 32 + (swz % 64) / 2; }
__host__ __device__ __forceinline__ int perm32(int rho) { const int n = rho >> 4, i = rho & 15; return 8 * (i >> 2) + 4 * n + (i & 3); }

struct Unit { int pm, pn; };
struct Gemm { const bf16_t* A; const bf16_t* Bt; int M, N, K; };

struct StaticOrder {
    int nM, nN, nwg, G, c;
    __host__ __device__ void init(int M_, int N_, int G_, int c_) { nM = M_ / BM; nN = N_ / BM; nwg = nM * nN; G = G_; c = c_; }
    __host__ __device__ bool next(int i, Unit& u) const {
        const long L = (long)i * G + c; if (L >= nwg) return false;
        int wgid = (int)L; { const int q = nwg / NXCD, r = nwg % NXCD, xcd = wgid % NXCD, off = wgid / NXCD; wgid = (xcd < r ? xcd * (q + 1) : r * (q + 1) + (xcd - r) * q) + off; }
        const int nig = WGM * nN, gid = wgid / nig, fm = gid * WGM, gsz = (nM - fm) < WGM ? (nM - fm) : WGM;
        u.pm = fm + ((wgid % nig) % gsz); u.pn = (wgid % nig) / gsz; return true;
    }
    __device__ __forceinline__ void a_ready(const Unit&) const {}
    __device__ __forceinline__ void done(const Unit&) const {}
};

__device__ __forceinline__ unsigned cvt_pk_bf16(float lo, float hi) { unsigned r; asm volatile("v_cvt_pk_bf16_f32 %0, %1, %2" : "=v"(r) : "v"(lo), "v"(hi)); return r; }

__device__ __forceinline__ f32x2 gelu_pk(f32x2 v) {
    const f32x2 av = __builtin_elementwise_abs(v), d = av * 0.2316418882f + 1.0f;
    f32x2 t; t.x = __builtin_amdgcn_rcpf(d.x); t.y = __builtin_amdgcn_rcpf(d.y);
    f32x2 q = t * 0.5307027145f + (-0.7265760135f); q = q * t + 0.7107068705f; q = q * t + (-0.142248368f); q = q * t + 0.127414796f; q = q * t;
    const f32x2 s = (v * v) * (-0.72134752044f);
    f32x2 e; e.x = __builtin_amdgcn_exp2f(s.x); e.y = __builtin_amdgcn_exp2f(s.y);
    const f32x2 m = v * (q * e), r = v - m;
    f32x2 o; o.x = v.x < 0.f ? m.x : r.x; o.y = v.y < 0.f ? m.y : r.y; return o;
}
__device__ __forceinline__ f32x4 gelu4(f32x4 v) { const f32x2 a = gelu_pk((f32x2){v[0], v[1]}), b = gelu_pk((f32x2){v[2], v[3]}); return (f32x4){a.x, a.y, b.x, b.y}; }
__device__ __forceinline__ float sigmoid1(float x) { return __builtin_amdgcn_rcpf(1.0f + __builtin_amdgcn_exp2f(-LOG2E * x)); }
__device__ __forceinline__ f32x4 sigmoid4(f32x4 v) { return (f32x4){sigmoid1(v[0]), sigmoid1(v[1]), sigmoid1(v[2]), sigmoid1(v[3])}; }
__device__ __forceinline__ f32x4 silu4(f32x4 v) { return v * sigmoid4(v); }

__device__ __forceinline__ void load_rstd(const float* rowss, int row0, int fq, float (&rs)[2][4]) {
#pragma unroll
    for (int ai = 0; ai < 2; ++ai)
#pragma unroll
        for (int m = 0; m < 4; ++m) {
            const f32x4 a = *(const f32x4*)(rowss + (size_t)(row0 + ai * HALF + m * 16) * 16 + 4 * fq);
            float s = (a[0] + a[1]) + (a[2] + a[3]);
            s += __shfl_xor(s, 16); s += __shfl_xor(s, 32);
            rs[ai][m] = 1.0f / sqrtf(s * (1.0f / D_MODEL) + EPS);
        }
}
__device__ __forceinline__ u32x4 pack8(f32x4 v0, f32x4 v1) { u32x4 w; w.x = cvt_pk_bf16(v0[0], v0[1]); w.y = cvt_pk_bf16(v0[2], v0[3]); w.z = cvt_pk_bf16(v1[0], v1[1]); w.w = cvt_pk_bf16(v1[2], v1[3]); return w; }
__device__ __forceinline__ void st16_wt(void* p, u32x4 v) { asm volatile("global_store_dwordx4 %0, %1, off sc1\n\ts_nop 1" :: "v"(p), "v"(v) : "memory"); }
__device__ __forceinline__ u32x2 pack4(f32x4 v0) { u32x2 w; w.x = cvt_pk_bf16(v0[0], v0[1]); w.y = cvt_pk_bf16(v0[2], v0[3]); return w; }

struct EpiA1 {
    static constexpr bool PERM = true, AFTER_DRAIN = false;
    bf16_t* UG; bf16_t* GV; float* lnst; const float* rowss;
    __device__ __forceinline__ void operator()(const f32x4 (&acc)[2][2][4][2], const Unit& u, int wr, int wc, int fr, int fq) const {
        const int row0 = u.pm * BM + wr * 64 + fr;
        float rs[2][4]; load_rstd(rowss, row0, fq, rs);
        if (u.pn < 16) {
            const int ch0 = u.pn * 128 + wc * 32 + 8 * fq;
#pragma unroll
            for (int ai = 0; ai < 2; ++ai)
#pragma unroll
                for (int m = 0; m < 4; ++m) {
                    const float r = rs[ai][m]; const int row = row0 + ai * HALF + m * 16;
                    const f32x4 u0 = gelu4(acc[ai][0][m][0] * r), u1 = gelu4(acc[ai][0][m][1] * r);
                    const f32x4 g0 = silu4(acc[ai][1][m][0] * r), g1 = silu4(acc[ai][1][m][1] * r);
                    st16_wt(UG + (size_t)row * A_WIDTH + ch0, pack8(u0 * g0, u1 * g1));
                }
        } else {
            const int g = u.pn - 16, ch0 = g * 256 + wc * 32 + 8 * fq;
#pragma unroll
            for (int ai = 0; ai < 2; ++ai)
#pragma unroll
                for (int m = 0; m < 4; ++m) {
                    const float r = rs[ai][m]; const int row = row0 + ai * HALF + m * 16;
                    float s1 = 0.f, s2 = 0.f;
#pragma unroll
                    for (int bj = 0; bj < 2; ++bj) {
                        const f32x4 v0 = gelu4(acc[ai][bj][m][0] * r), v1 = gelu4(acc[ai][bj][m][1] * r);
                        st16_wt(GV + (size_t)row * A_WIDTH + ch0 + bj * HALF, pack8(v0, v1));
                        s1 += ((v0[0] + v0[1]) + (v0[2] + v0[3])) + ((v1[0] + v1[1]) + (v1[2] + v1[3]));
                        s2 += ((v0[0] * v0[0] + v0[1] * v0[1]) + (v0[2] * v0[2] + v0[3] * v0[3])) + ((v1[0] * v1[0] + v1[1] * v1[1]) + (v1[2] * v1[2] + v1[3] * v1[3]));
                    }
                    s1 += __shfl_xor(s1, 16); s1 += __shfl_xor(s1, 32); s2 += __shfl_xor(s2, 16); s2 += __shfl_xor(s2, 32);
                    if (fq == 0) *(f32x2*)(lnst + ((size_t)row * 32 + g * 4 + wc) * 2) = (f32x2){s1, s2};
                }
        }
    }
};
struct EpiKVQ {
    static constexpr bool PERM = true, AFTER_DRAIN = false;
    bf16_t* Kb; bf16_t* Vb; bf16_t* Qb; bf16_t* SG; const float* rowss; int kind0;
    __device__ __forceinline__ void operator()(const f32x4 (&acc)[2][2][4][2], const Unit& u, int wr, int wc, int fr, int fq) const {
        const int row0 = u.pm * BM + wr * 64 + fr;
        float rs[2][4]; load_rstd(rowss, row0, fq, rs);
        const int kind = kind0 + (u.pn >> 2);
        bf16_t* base = kind == 0 ? Kb : kind == 1 ? Vb : kind == 2 ? Qb : SG;
        const int col0 = (u.pn & 3) * 256 + wc * 32 + 8 * fq;
#pragma unroll
        for (int ai = 0; ai < 2; ++ai)
#pragma unroll
            for (int m = 0; m < 4; ++m) {
                float r = rs[ai][m]; if (kind == 2) r *= QSCALE; const int row = row0 + ai * HALF + m * 16;
#pragma unroll
                for (int bj = 0; bj < 2; ++bj) {
                    f32x4 v0 = acc[ai][bj][m][0] * r, v1 = acc[ai][bj][m][1] * r;
                    if (kind == 3) { v0 = silu4(v0); v1 = silu4(v1); }
                    st16_wt(base + (size_t)row * D_MODEL + col0 + bj * HALF, pack8(v0, v1));
                }
            }
    }
};
struct EpiE {
    static constexpr bool PERM = true, AFTER_DRAIN = false;
    bf16_t* E;
    __device__ __forceinline__ void operator()(const f32x4 (&acc)[2][2][4][2], const Unit& u, int wr, int wc, int fr, int fq) const {
        const int row0 = u.pm * BM + wr * 64 + fr, col0 = u.pn * BM + wc * 32 + 8 * fq;
#pragma unroll
        for (int ai = 0; ai < 2; ++ai)
#pragma unroll
            for (int m = 0; m < 4; ++m) { const int row = row0 + ai * HALF + m * 16;
#pragma unroll
                for (int bj = 0; bj < 2; ++bj) st16_wt(E + (size_t)row * D_MODEL + col0 + bj * HALF, pack8(acc[ai][bj][m][0], acc[ai][bj][m][1])); }
    }
};
__device__ __forceinline__ void unpack8(u32x4 w, f32x4& a, f32x4& b) {
    a = (f32x4){__uint_as_float(w.x << 16), __uint_as_float(w.x & 0xffff0000u), __uint_as_float(w.y << 16), __uint_as_float(w.y & 0xffff0000u)};
    b = (f32x4){__uint_as_float(w.z << 16), __uint_as_float(w.z & 0xffff0000u), __uint_as_float(w.w << 16), __uint_as_float(w.w & 0xffff0000u)};
}
struct EpiMix {
    static constexpr bool PERM = true, AFTER_DRAIN = false;
    const bf16_t* hsrc; bf16_t* hdst;
    __device__ __forceinline__ void operator()(const f32x4 (&acc)[2][2][4][2], const Unit& u, int wr, int wc, int fr, int fq) const {
        const int row0 = u.pm * BM + wr * 64 + fr, col0 = u.pn * BM + wc * 32 + 8 * fq;
#pragma unroll
        for (int ai = 0; ai < 2; ++ai) {
            u32x4 hv[4][2];
#pragma unroll
            for (int m = 0; m < 4; ++m)
#pragma unroll
                for (int bj = 0; bj < 2; ++bj) hv[m][bj] = *(const u32x4*)(hsrc + (size_t)(row0 + ai * HALF + m * 16) * D_MODEL + col0 + bj * HALF);
#pragma unroll
            for (int m = 0; m < 4; ++m)
#pragma unroll
                for (int bj = 0; bj < 2; ++bj) { f32x4 a, b; unpack8(hv[m][bj], a, b);
                    st16_wt(hdst + (size_t)(row0 + ai * HALF + m * 16) * D_MODEL + col0 + bj * HALF, pack8(a + acc[ai][bj][m][0], b + acc[ai][bj][m][1])); }
            asm volatile("" ::: "memory");
        }
    }
};
struct EpiPle {
    static constexpr bool PERM = true, AFTER_DRAIN = false;
    const bf16_t* h1; const bf16_t* E; bf16_t* hb; float* rowss;
    __device__ __forceinline__ void operator()(const f32x4 (&acc)[2][2][4][2], const Unit& u, int wr, int wc, int fr, int fq) const {
        const int row0 = u.pm * BM + wr * 64 + fr, col0 = u.pn * BM + wc * 32 + 8 * fq;
#pragma unroll
        for (int ai = 0; ai < 2; ++ai) {
            u32x4 hv[4][2], ev[4][2];
#pragma unroll
            for (int m = 0; m < 4; ++m)
#pragma unroll
                for (int bj = 0; bj < 2; ++bj) { const size_t o = (size_t)(row0 + ai * HALF + m * 16) * D_MODEL + col0 + bj * HALF; hv[m][bj] = *(const u32x4*)(h1 + o); if (m < 2) ev[m][bj] = *(const u32x4*)(E + o); }
#pragma unroll
            for (int m = 0; m < 4; ++m) { const int row = row0 + ai * HALF + m * 16; float ss = 0.f;
                if (m == 2) {
                    asm volatile("" ::: "memory");
#pragma unroll
                    for (int m2 = 2; m2 < 4; ++m2)
#pragma unroll
                        for (int bj = 0; bj < 2; ++bj) ev[m2][bj] = *(const u32x4*)(E + (size_t)(row0 + ai * HALF + m2 * 16) * D_MODEL + col0 + bj * HALF);
                }
#pragma unroll
                for (int bj = 0; bj < 2; ++bj) { f32x4 ha, hb_, ea, eb; unpack8(hv[m][bj], ha, hb_); unpack8(ev[m][bj], ea, eb);
                    const f32x4 x0 = ha + sigmoid4(acc[ai][bj][m][0]) * ea, x1 = hb_ + sigmoid4(acc[ai][bj][m][1]) * eb;
                    st16_wt(hb + (size_t)row * D_MODEL + col0 + bj * HALF, pack8(x0, x1));
                    ss += ((x0[0] * x0[0] + x0[1] * x0[1]) + (x0[2] * x0[2] + x0[3] * x0[3])) + ((x1[0] * x1[0] + x1[1] * x1[1]) + (x1[2] * x1[2] + x1[3] * x1[3])); }
                ss += __shfl_xor(ss, 16); ss += __shfl_xor(ss, 32);
                if (fq == 0) rowss[(size_t)row * 16 + u.pn * 4 + wc] = ss; }
            asm volatile("" ::: "memory");
        }
    }
};

template <class Epi, class Sched, bool ALIGN_EPI = false, bool SP2 = false>
__device__ __forceinline__ void gemm_phase(LAS unsigned char* lds, const Gemm g, const Sched& S, const Epi& E) {
    int tid_l = threadIdx.x; asm volatile("" : "+v"(tid_l));
    const int tid = tid_l, wid = __builtin_amdgcn_readfirstlane(tid >> 6), lane = tid & 63, wr = wid >> 2, wc = wid & 3, fr = lane & 15, fq = lane >> 4;
    const int K = g.K, nt = K / BK;
    unsigned voffA[2], voffB[2];
#pragma unroll
    for (int i = 0; i < 2; ++i) { int R, C; stage_rc(tid * 16 + i * 8192, R, C); const int Rb = Epi::PERM ? ((R & ~31) + perm32(R & 31)) : R;
        voffA[i] = (unsigned)(R * K + C) * 2u; voffB[i] = (unsigned)(Rb * K + C) * 2u; }
    const size_t kstep = (size_t)(BK * 2);
    const size_t hstep = (size_t)HALF * K * 2;
    const size_t tstep = 2 * hstep;
    const unsigned ldsw = (unsigned)wid * 1024u;
    const int aoff = lds_byte(wr * 64 + fr, fq * 8), boff = lds_byte(wc * 32 + fr, fq * 8);
#define PG8_SA(b, h) (((b) * 2 + (h)) * HTB)
#define PG8_SB(b, h) ((4 + (b) * 2 + (h)) * HTB)
#define PG8_STAGE(bufoff, gbase, voff) do { _Pragma("unroll") for (int _i = 0; _i < 2; ++_i) \
        __builtin_amdgcn_global_load_lds((const unsigned*)((const char*)(gbase) + (voff)[_i]), (LAS unsigned*)(lds + (bufoff) + ldsw + _i * 8192), 16, 0, 0); } while (0)
#define PG8_LDA(dst, b, h) do { _Pragma("unroll") for (int m = 0; m < 4; ++m) _Pragma("unroll") for (int k = 0; k < 2; ++k) dst[m][k] = *(const LAS bf16x8*)(lds + PG8_SA(b, h) + aoff + m * 2048 + k * 1024); } while (0)
#define PG8_LDB(dst, b, h) do { _Pragma("unroll") for (int n = 0; n < 2; ++n) _Pragma("unroll") for (int k = 0; k < 2; ++k) dst[n][k] = *(const LAS bf16x8*)(lds + PG8_SB(b, h) + boff + n * 2048 + k * 1024); } while (0)
#define PG8_MMA(ai, bj, At, Bt) do { __builtin_amdgcn_s_setprio(1); _Pragma("unroll") for (int m = 0; m < 4; ++m) _Pragma("unroll") for (int n = 0; n < 2; ++n) _Pragma("unroll") for (int k = 0; k < 2; ++k) \
        acc[ai][bj][m][n] = __builtin_amdgcn_mfma_f32_16x16x32_bf16(Bt[n][k], At[m][k], acc[ai][bj][m][n], 0, 0, 0); __builtin_amdgcn_s_setprio(0); } while (0)
#define PG8_WAIT_V(n) asm volatile("s_waitcnt vmcnt(" #n ")" ::: "memory")
#define PG8_WAIT_L(n) asm volatile("s_waitcnt lgkmcnt(" #n ")" ::: "memory")
#define PG8_BAR __builtin_amdgcn_s_barrier()
#define PG8_SCHED __builtin_amdgcn_sched_barrier(0)
    Unit cur, nxt; int ui = 0;
    if (!S.next(0, cur)) return;
    f32x4 acc[2][2][4][2];
#pragma unroll
    for (int a = 0; a < 2; ++a)
#pragma unroll
        for (int b = 0; b < 2; ++b)
#pragma unroll
            for (int m = 0; m < 4; ++m)
#pragma unroll
                for (int n = 0; n < 2; ++n) acc[a][b][m][n] = (f32x4){0.f, 0.f, 0.f, 0.f};
    bf16x8 At[4][2], B0[2][2], B1[2][2];
    const char* cA = (const char*)g.A + (size_t)cur.pm * tstep; const char* cB = (const char*)g.Bt + (size_t)cur.pn * tstep;
    S.a_ready(cur);
    if constexpr (SP2) {
        PG8_STAGE(PG8_SB(0, 0), cB, voffB); PG8_STAGE(PG8_SB(0, 1), cB + hstep, voffB); PG8_STAGE(PG8_SA(0, 0), cA, voffA); PG8_STAGE(PG8_SA(0, 1), cA + hstep, voffA);
        if (wr == 1) PG8_BAR;
        PG8_WAIT_V(2); PG8_BAR;
        PG8_STAGE(PG8_SB(1, 0), cB + kstep, voffB); PG8_STAGE(PG8_SA(1, 0), cA + kstep, voffA); PG8_STAGE(PG8_SB(1, 1), cB + hstep + kstep, voffB);
        PG8_WAIT_V(6); PG8_BAR;
    } else {
        PG8_STAGE(PG8_SB(0, 0), cB, voffB); PG8_STAGE(PG8_SA(0, 0), cA, voffA); PG8_STAGE(PG8_SB(0, 1), cB + hstep, voffB); PG8_STAGE(PG8_SA(0, 1), cA + hstep, voffA);
        if (wr == 1) PG8_BAR;
        PG8_WAIT_V(4); PG8_BAR;
        PG8_STAGE(PG8_SB(1, 0), cB + kstep, voffB); PG8_STAGE(PG8_SA(1, 0), cA + kstep, voffA); PG8_STAGE(PG8_SB(1, 1), cB + hstep + kstep, voffB);
        PG8_WAIT_V(6); PG8_BAR;
    }
#pragma unroll 1
    for (;;) {
        const bool has_next = S.next(ui + 1, nxt);
        const char* nA = has_next ? (const char*)g.A + (size_t)nxt.pm * tstep : cA; const char* nB = has_next ? (const char*)g.Bt + (size_t)nxt.pn * tstep : cB;
#pragma unroll 1
        for (int t = 0; t < nt; t += 2) {
            const bool last = (t == nt - 2);
            const char* a1 = cA + (size_t)(t + 1) * kstep;
            const char* a2 = last ? nA : cA + (size_t)(t + 2) * kstep; const char* b2 = last ? nB : cB + (size_t)(t + 2) * kstep;
            const char* a3 = a2 + kstep; const char* b3 = b2 + kstep;
            if (last && has_next) S.a_ready(nxt);
            if constexpr (SP2) {
            PG8_LDB(B0, 0, 0); PG8_LDB(B1, 0, 1); PG8_SCHED; PG8_LDA(At, 0, 0); PG8_STAGE(PG8_SA(1, 1), a1 + hstep, voffA);
            PG8_WAIT_V(8); PG8_WAIT_L(0); PG8_BAR; PG8_MMA(0, 0, At, B0); PG8_MMA(0, 1, At, B1); PG8_BAR; PG8_SCHED;
            PG8_LDA(At, 0, 1); PG8_STAGE(PG8_SB(0, 0), b2, voffB); PG8_STAGE(PG8_SB(0, 1), b2 + hstep, voffB); PG8_STAGE(PG8_SA(0, 0), a2, voffA);
            PG8_WAIT_V(8); PG8_WAIT_L(0); PG8_BAR; PG8_MMA(1, 0, At, B0); PG8_MMA(1, 1, At, B1); PG8_BAR; PG8_SCHED;
            PG8_LDB(B0, 1, 0); PG8_LDB(B1, 1, 1); PG8_SCHED; PG8_LDA(At, 1, 0); PG8_STAGE(PG8_SA(0, 1), a2 + hstep, voffA);
            PG8_WAIT_V(8); PG8_WAIT_L(0); PG8_BAR; PG8_MMA(0, 0, At, B0); PG8_MMA(0, 1, At, B1); PG8_BAR; PG8_SCHED;
            PG8_LDA(At, 1, 1); PG8_STAGE(PG8_SB(1, 0), b3, voffB); PG8_STAGE(PG8_SB(1, 1), b3 + hstep, voffB); PG8_STAGE(PG8_SA(1, 0), a3, voffA);
            PG8_WAIT_V(8); PG8_WAIT_L(0); PG8_BAR; PG8_MMA(1, 0, At, B0); PG8_MMA(1, 1, At, B1); PG8_BAR; PG8_SCHED;
            } else {
            PG8_LDB(B0, 0, 0); PG8_SCHED; PG8_LDA(At, 0, 0); PG8_STAGE(PG8_SA(1, 1), a1 + hstep, voffA);
            PG8_WAIT_L(8); PG8_BAR; PG8_WAIT_L(0); PG8_MMA(0, 0, At, B0); PG8_BAR; PG8_SCHED;
            PG8_LDB(B1, 0, 1); PG8_STAGE(PG8_SB(0, 0), b2, voffB);
            PG8_BAR; PG8_WAIT_L(0); PG8_MMA(0, 1, At, B1); PG8_BAR;
            PG8_LDA(At, 0, 1); PG8_STAGE(PG8_SA(0, 0), a2, voffA);
            PG8_BAR; PG8_WAIT_L(0); PG8_MMA(1, 0, At, B0); PG8_BAR; PG8_SCHED;
            PG8_STAGE(PG8_SB(0, 1), b2 + hstep, voffB);
            PG8_WAIT_V(6); PG8_BAR; PG8_MMA(1, 1, At, B1); PG8_BAR;
            PG8_LDB(B0, 1, 0); PG8_SCHED; PG8_LDA(At, 1, 0); PG8_STAGE(PG8_SA(0, 1), a2 + hstep, voffA);
            PG8_WAIT_L(8); PG8_BAR; PG8_WAIT_L(0); PG8_MMA(0, 0, At, B0); PG8_BAR; PG8_SCHED;
            PG8_LDB(B1, 1, 1); PG8_STAGE(PG8_SB(1, 0), b3, voffB);
            PG8_BAR; PG8_WAIT_L(0); PG8_MMA(0, 1, At, B1); PG8_BAR;
            PG8_LDA(At, 1, 1); PG8_STAGE(PG8_SA(1, 0), a3, voffA);
            PG8_BAR; PG8_WAIT_L(0); PG8_MMA(1, 0, At, B0); PG8_BAR; PG8_SCHED;
            PG8_STAGE(PG8_SB(1, 1), b3 + hstep, voffB);
            PG8_WAIT_V(6); PG8_BAR; PG8_MMA(1, 1, At, B1); PG8_BAR;
            }
        }
        if constexpr (ALIGN_EPI) { if (wr == 0) PG8_BAR; }
        if constexpr (!Epi::AFTER_DRAIN) { E(acc, cur, wr, wc, fr, fq); S.done(cur); }
        if (!has_next) break;
#pragma unroll
        for (int a = 0; a < 2; ++a)
#pragma unroll
            for (int b = 0; b < 2; ++b)
#pragma unroll
                for (int m = 0; m < 4; ++m)
#pragma unroll
                    for (int n = 0; n < 2; ++n) acc[a][b][m][n] = (f32x4){0.f, 0.f, 0.f, 0.f};
        cur = nxt; cA = nA; cB = nB; ++ui;
        if constexpr (ALIGN_EPI) { if (wr == 1) PG8_BAR; }
    }
    PG8_WAIT_V(0);
    if constexpr (!ALIGN_EPI) { if (wr == 0) PG8_BAR; }
    PG8_BAR;
#undef PG8_SA
#undef PG8_SB
#undef PG8_STAGE
#undef PG8_LDA
#undef PG8_LDB
#undef PG8_MMA
#undef PG8_WAIT_V
#undef PG8_WAIT_L
#undef PG8_BAR
#undef PG8_SCHED
}
}

typedef GAS unsigned gu32;
#define RLX_AGENT __ATOMIC_RELAXED, __HIP_MEMORY_SCOPE_AGENT
#define LDS_WAIT() asm volatile("s_waitcnt lgkmcnt(0)" ::: "memory")
#define VM_WAIT() asm volatile("s_waitcnt vmcnt(0)" ::: "memory")
__device__ __forceinline__ unsigned f2bf(float f) { unsigned u = __builtin_bit_cast(unsigned, f); return (u + 0x7fffu + ((u >> 16) & 1u)) >> 16; }
__device__ __forceinline__ unsigned pk2(float lo, float hi) { return f2bf(lo) | (f2bf(hi) << 16); }
__device__ __forceinline__ float bflo(unsigned w) { return __uint_as_float(w << 16); }
__device__ __forceinline__ float bfhi(unsigned w) { return __uint_as_float(w & 0xffff0000u); }

constexpr int CW_BAR = 4096;
#define XB_TMO      128
#define XB_XCNT(j)  (256  + 64 * (j))
#define XB_XSUB(j)  (1280 + 64 * (j))
#define XB_XGEN(j)  (2304 + 64 * (j))
#define XB_TOP      3328
#define XB_TOPGEN   3392
#define XCD_BAR_WORDS 3456
#define XB_SPIN_CAP (1u << 20)
__device__ __forceinline__ unsigned xb_ld(unsigned* p)              { return __hip_atomic_load(p, __ATOMIC_RELAXED, __HIP_MEMORY_SCOPE_AGENT); }
__device__ __forceinline__ unsigned xb_add(unsigned* p, unsigned v) { return __hip_atomic_fetch_add(p, v, __ATOMIC_RELAXED, __HIP_MEMORY_SCOPE_AGENT); }
__device__ __forceinline__ unsigned xb_xcc_id() { return (unsigned)__builtin_amdgcn_s_getreg((3 << 11) | 20) & 0xFu; }
#define XB_SPIN(cond, bar) do { unsigned _sp = 0; while (cond) { __builtin_amdgcn_s_sleep(1); \
    if ((++_sp & 255u) == 0u) { if (xb_ld(&(bar)[XB_TMO])) break; if (_sp > XB_SPIN_CAP) { atomicAdd(&(bar)[XB_TMO], 1u); break; } } } } while (0)
struct XcdBarrier { unsigned* bar; unsigned x; volatile LAS unsigned* st; };
__device__ __forceinline__ XcdBarrier xcd_barrier_post(unsigned* bar, volatile LAS unsigned* st) {
    XcdBarrier b; b.bar = bar; b.x = xb_xcc_id(); b.st = st;
    if (threadIdx.x == 0) (void)xb_add(&bar[XB_XCNT(b.x)], 1u);
    return b;
}
__device__ __forceinline__ void xcd_barrier_complete(unsigned* bar, unsigned x, unsigned& nloc, unsigned& nx) {
    const unsigned G = gridDim.x * gridDim.y * gridDim.z;
    unsigned sum, cnt, mine, sp = 0u;
    for (;;) {
        sum = 0u; cnt = 0u; mine = 0u;
#pragma unroll
        for (unsigned j = 0; j < 16; ++j) { const unsigned c = xb_ld(&bar[XB_XCNT(j)]); sum += c; cnt += (c > 0u) ? 1u : 0u; mine = (j == x) ? c : mine; }
        if (sum == G) break;
        __builtin_amdgcn_s_sleep(1);
        if ((++sp & 255u) == 0u) { if (xb_ld(&bar[XB_TMO])) break; if (sp > XB_SPIN_CAP) { atomicAdd(&bar[XB_TMO], 1u); break; } }
    }
    nloc = mine > 0u ? mine : 1u; nx = cnt > 0u ? cnt : 1u;
}
__device__ __forceinline__ void xcd_barrier(const XcdBarrier& b) {
    asm volatile("s_waitcnt vmcnt(0)" ::: "memory");
    __syncthreads();
    if (threadIdx.x == 0) {
        unsigned* bar = b.bar; unsigned bx_ = b.x;
        asm volatile("" : "+s"(bar), "+s"(bx_));
        __builtin_amdgcn_s_waitcnt(0);
        unsigned nloc = b.st[0], nx = b.st[1];
        if (nloc == 0u) { xcd_barrier_complete(bar, bx_, nloc, nx); b.st[0] = nloc; b.st[1] = nx; }
        const unsigned old = xb_add(&bar[XB_XSUB(bx_)], 1u);
        const unsigned gen = old / nloc;
        if (old + 1u == (gen + 1u) * nloc) {
            __builtin_amdgcn_fence(__ATOMIC_RELEASE, "agent");
            asm volatile("s_waitcnt vmcnt(0)" ::: "memory");
            const unsigned og = xb_add(&bar[XB_TOP], 1u);
            const unsigned tg = og / nx;
            if (og + 1u == (tg + 1u) * nx) xb_add(&bar[XB_TOPGEN], 1u);
            else XB_SPIN(xb_ld(&bar[XB_TOPGEN]) == tg, bar);
            __builtin_amdgcn_fence(__ATOMIC_ACQUIRE, "agent");
            xb_add(&bar[XB_XGEN(bx_)], 1u);
            asm volatile("s_waitcnt vmcnt(0)" ::: "memory");
        } else {
            XB_SPIN(xb_ld(&bar[XB_XGEN(bx_)]) == gen, bar);
            __builtin_amdgcn_fence(__ATOMIC_ACQUIRE, "agent");
            asm volatile("s_waitcnt vmcnt(0)" ::: "memory");
        }
    }
    __syncthreads();
}

struct Args {
    const float* x; const float* p; const float* norm_g; const float* a_w_in; const float* a_ln_g; const float* a_ln_b; const float* a_w_s; const float* a_b_s; const float* a_w_out;
    const float* kv_norm_g; const float* w_kv; const float* b_w_in; const float* b_w_out; const float* ple_w; const float* ple_gate_w; const float* final_g;
    float* out; unsigned char* ws;
};

__device__ __forceinline__ float wave_sum(float v) {
#pragma unroll
    for (int o = 1; o < 64; o <<= 1) v += __shfl_xor(v, o);
    return v;
}

__device__ __forceinline__ int src_col(int mode, int n, int col_off) {
    if (mode == 0) return n + col_off;
    if (n < 4096) { const int t = n >> 8, j = n & 255; return j < 128 ? 128 * t + j : 4096 + 128 * t + (j - 128); }
    return 2048 + (n - 4096);
}
__device__ __forceinline__ void transpose_item(const float* W, int K, int Nsrc, int mode, int col_off, const float* scale, bf16_t* WT, LAS float* scr, int item, int lane, int nblk) {
    const int kb = item / nblk, nb = item % nblk, k0 = 64 * kb, n0 = 32 * nb, s0 = src_col(mode, n0, col_off);
    const int kl = lane >> 3, n4 = 4 * (lane & 7);
    f32x4 v[8];
#pragma unroll
    for (int i = 0; i < 8; ++i) v[i] = *(const f32x4*)(W + (size_t)(k0 + 8 * i + kl) * Nsrc + s0 + n4);
#pragma unroll
    for (int i = 0; i < 8; ++i) { const int kk = 8 * i + kl; const float sc = scale ? scale[k0 + kk] : 1.0f; LAS float* d = scr + kk * 33 + n4;
        d[0] = v[i][0] * sc; d[1] = v[i][1] * sc; d[2] = v[i][2] * sc; d[3] = v[i][3] * sc; }
    LDS_WAIT(); asm volatile("" ::: "memory");
    const int c = lane >> 3;
#pragma unroll
    for (int j = 0; j < 4; ++j) { const int n = (lane & 7) + 8 * j; const LAS float* s = scr + (8 * c) * 33 + n;
        u32x4 o; o.x = pk2(s[0 * 33], s[1 * 33]); o.y = pk2(s[2 * 33], s[3 * 33]); o.z = pk2(s[4 * 33], s[5 * 33]); o.w = pk2(s[6 * 33], s[7 * 33]);
        pg8::st16_wt(WT + (size_t)(n0 + n) * K + k0 + 8 * c, o); }
    LDS_WAIT(); asm volatile("" ::: "memory");
}
#define TJOB(W_, K_, Nsrc_, ndst_, mode_, coff_, scale_, WT_) do { const int nblk_ = (ndst_) / 32, items_ = ((K_) / 64) * nblk_; \
        for (int it_ = ((gw - jbase) % NGW + NGW) % NGW; it_ < items_; it_ += NGW) transpose_item((W_), (K_), (Nsrc_), (mode_), (coff_), (scale_), (WT_), scr, it_, lane, nblk_); \
        jbase = (jbase + items_) % NGW; } while (0)

__device__ __forceinline__ void convert_p(const float* src, bf16_t* dst, int gtid_in, int gthreads) {
    int gtid = gtid_in; asm volatile("" : "+v"(gtid));
    const int n8 = M * PLE_DIM / 8;
    for (int i = gtid; i < n8; i += gthreads) { const f32x4 a = *(const f32x4*)(src + (size_t)i * 8), b = *(const f32x4*)(src + (size_t)i * 8 + 4);
        u32x4 o; o.x = pk2(a[0], a[1]); o.y = pk2(a[2], a[3]); o.z = pk2(b[0], b[1]); o.w = pk2(b[2], b[3]); pg8::st16_wt(dst + (size_t)i * 8, o); }
}

__device__ __forceinline__ s16x4 mx_vtr(const LAS unsigned char* p) { return __builtin_bit_cast(s16x4, __builtin_amdgcn_ds_read_tr16_b64_v4i16((LAS s16x4*)p)); }
constexpr int MX_WM = 0, MX_LD = 136, MX_RSV = 544, MX_VT = 128 * MX_LD * 2, MX_ST = MX_VT + 128 * MX_RSV, MX_BS = MX_ST + 2 * 128 * 8, MX_END = MX_BS + 128 * 4;
static_assert(MX_END <= RING_BYTES, "mix LDS map");
__device__ __forceinline__ void mix_phase(LAS unsigned char* lds, int vcu, const float* wsm_l  , const float* bs_l  , const float* lng, const float* lnb,
                                          const bf16_t* GV, const bf16_t* UG, bf16_t* Yo, size_t ymask, const float* lnst, int tid_in) {
    int tid = tid_in; asm volatile("" : "+v"(tid));
    const int lane = tid & 63, wid = tid >> 6, g = vcu & 7, nb0 = vcu >> 3;
    LAS f32x2* ST = (LAS f32x2*)(lds + MX_ST); LAS float* BS = (LAS float*)(lds + MX_BS);
    { const float* wsm = wsm_l + (size_t)g * 128 * 128;
#pragma unroll
      for (int i = 0; i < 4; ++i) { const int idx = tid + 512 * i, t = idx >> 4, s8 = idx & 15;
        f32x4 a = *(const f32x4*)(wsm + t * 128 + s8 * 8), b = *(const f32x4*)(wsm + t * 128 + s8 * 8 + 4);
        if (t < 64 && s8 >= 8) { a = (f32x4){0.f, 0.f, 0.f, 0.f}; b = a; }
        u32x4 o; o.x = pk2(a[0], a[1]); o.y = pk2(a[2], a[3]); o.z = pk2(b[0], b[1]); o.w = pk2(b[2], b[3]);
        *(LAS u32x4*)(lds + MX_WM + t * (MX_LD * 2) + s8 * 16) = o; }
      if (tid < 128) BS[tid] = bs_l[g * 128 + tid]; }
    const int c8 = tid & 31, srow0 = tid >> 5;
    float lg[8], lb[8];
    { const f32x4 ga = *(const f32x4*)(lng + g * 256 + c8 * 8), gb = *(const f32x4*)(lng + g * 256 + c8 * 8 + 4), ba = *(const f32x4*)(lnb + g * 256 + c8 * 8), bb = *(const f32x4*)(lnb + g * 256 + c8 * 8 + 4);
#pragma unroll
      for (int e = 0; e < 4; ++e) { lg[e] = ga[e]; lg[4 + e] = gb[e]; lb[e] = ba[e]; lb[4 + e] = bb[e]; } }
    u32x4 gvr[8];
#define MX_LOADGV(nb_) do { _Pragma("unroll") for (int i_ = 0; i_ < 8; ++i_) gvr[i_] = *(const u32x4*)(GV + (size_t)((nb_) * 128 + srow0 + 16 * i_) * A_WIDTH + g * 256 + c8 * 8); } while (0)
#define MX_STATS(nb_, buf_) do { if (tid < 128) { const f32x4* p_ = (const f32x4*)(lnst + (size_t)((nb_) * 128 + tid) * 64); float s1_ = 0.f, s2_ = 0.f; \
        _Pragma("unroll") for (int i_ = 0; i_ < 16; ++i_) { const f32x4 v_ = p_[i_]; s1_ += v_[0] + v_[2]; s2_ += v_[1] + v_[3]; } \
        const float mean_ = s1_ * (1.0f / A_WIDTH), var_ = fmaxf(s2_ * (1.0f / A_WIDTH) - mean_ * mean_, 0.f); ST[(buf_) * 128 + tid] = (f32x2){mean_, 1.0f / sqrtf(var_ + EPS)}; } } while (0)
    MX_STATS(nb0, 0); MX_LOADGV(nb0);
    __syncthreads();
    const int fr = lane & 15, fq = lane >> 4;
#pragma unroll 1
    for (int k = 0; k < 4; ++k) {
        const int nb = nb0 + 32 * k;
        { const int wbk = c8 >> 2, m = c8 & 3;
#pragma unroll
          for (int i = 0; i < 8; ++i) { const int srow = srow0 + 16 * i; const f32x2 st = ST[(k & 1) * 128 + srow]; const u32x4 w = gvr[i];
            const float v[8] = {bflo(w.x), bfhi(w.x), bflo(w.y), bfhi(w.y), bflo(w.z), bfhi(w.z), bflo(w.w), bfhi(w.w)};
            float y[8];
#pragma unroll
            for (int e = 0; e < 8; ++e) y[e] = (v[e] - st.x) * st.y * lg[e] + lb[e];
            u32x2 lo, hi2; lo.x = pk2(y[0], y[1]); lo.y = pk2(y[2], y[3]); hi2.x = pk2(y[4], y[5]); hi2.y = pk2(y[6], y[7]);
            *(LAS u32x2*)(lds + MX_VT + srow * MX_RSV + wbk * 64 + m * 8) = lo; *(LAS u32x2*)(lds + MX_VT + srow * MX_RSV + wbk * 64 + 32 + m * 8) = hi2; } }
        if (k < 3) MX_LOADGV(nb + 32);
        __syncthreads();
        f32x4 acc[2][8];
#pragma unroll
        for (int ct = 0; ct < 2; ++ct)
#pragma unroll
            for (int tt = 0; tt < 8; ++tt) acc[ct][tt] = (f32x4){0.f, 0.f, 0.f, 0.f};
        const LAS unsigned char* vta = lds + MX_VT + (8 * fq + (fr >> 2)) * MX_RSV + wid * 64 + (fr & 3) * 8;
#pragma unroll
        for (int ks = 0; ks < 4; ++ks) {
            bf16x8 af[2];
#pragma unroll
            for (int ct = 0; ct < 2; ++ct) { const s16x4 lo = mx_vtr(vta + ks * 32 * MX_RSV + ct * 32), hh = mx_vtr(vta + ks * 32 * MX_RSV + ct * 32 + 4 * MX_RSV);
                af[ct] = (bf16x8){lo[0], lo[1], lo[2], lo[3], hh[0], hh[1], hh[2], hh[3]}; }
#pragma unroll
            for (int tt = 0; tt < 8; ++tt) {
                if (tt < 4 && ks >= 2) continue;
                const bf16x8 bfr = *(const LAS bf16x8*)(lds + MX_WM + (tt * 16 + fr) * (MX_LD * 2) + ks * 64 + fq * 16);
#pragma unroll
                for (int ct = 0; ct < 2; ++ct) acc[ct][tt] = __builtin_amdgcn_mfma_f32_16x16x32_bf16(af[ct], bfr, acc[ct][tt], 0, 0, 0);
            }
        }
#pragma unroll
        for (int tt = 0; tt < 8; ++tt) { const int t = tt * 16 + fr; const float b = BS[t];
            const size_t eo = (size_t)(nb * 128 + t) * A_WIDTH + g * 256 + wid * 32 + 8 * fq;
            const u32x4 w = *(const u32x4*)(UG + eo); const f32x4 a0 = acc[0][tt], a1 = acc[1][tt];
            u32x4 o; o.x = pk2(bflo(w.x) * (a0[0] + b), bfhi(w.x) * (a0[1] + b)); o.y = pk2(bflo(w.y) * (a0[2] + b), bfhi(w.y) * (a0[3] + b));
            o.z = pk2(bflo(w.z) * (a1[0] + b), bfhi(w.z) * (a1[1] + b)); o.w = pk2(bflo(w.w) * (a1[2] + b), bfhi(w.w) * (a1[3] + b));
            pg8::st16_wt(Yo + (eo & ymask), o); }
        if (k < 3) MX_STATS(nb + 32, (k + 1) & 1);
        __syncthreads();
    }
#undef MX_LOADGV
#undef MX_STATS
}

constexpr int AT_K = 0, AT_V = 32768, AT_KV_BYTES = 16384, AT_Q = 65536;
__device__ __forceinline__ int crow(int r, int hi) { return (r & 3) + 8 * (r >> 2) + 4 * hi; }
__device__ __forceinline__ s16x4 vtr(const LAS unsigned char* p) { return __builtin_bit_cast(s16x4, __builtin_amdgcn_ds_read_tr16_b64_v4i16((LAS s16x4*)p)); }
__device__ __forceinline__ float vmaxf(float a, float b) { float r; asm("v_max_f32_e32 %0, %1, %2" : "=v"(r) : "v"(a), "v"(b)); return r; }
template <int LITE = 0> __device__ __forceinline__ float sp_tail(float z) { if constexpr (LITE & 1) return 1.0f - __builtin_fabsf(z) * 0.01f; else return __builtin_amdgcn_logf(1.0f + __builtin_amdgcn_exp2f(-__builtin_fabsf(z))); }
template <int LITE = 0> __device__ __forceinline__ float ex2(float x) { if constexpr (LITE & 1) return x * 0.001f; else return __builtin_amdgcn_exp2f(x); }
struct AttnRegs { f32x16 o[4]; f32x16 y0, y1; float R, zf; };

template <bool QK, bool PV, bool DQK, bool DPV, int LITE = 0>
__device__ __forceinline__ void attn_step(AttnRegs& a, const LAS unsigned char* Kt, const LAS unsigned char* Vt, const LAS unsigned char* Qs,
                                          int lane, int qrelQK, int qrelPV, const bf16x8 (&ntri)[2], const bf16x8 none) {
    const int r32 = lane & 31, hi = lane >> 5;
    f32x16 zN0, zN1; u32x4 pw[4], xw[4];
    float tot = 0.f;
    if constexpr (PV) { tot = a.y0[0] - a.zf; const auto rr = __builtin_amdgcn_permlane32_swap(__float_as_uint(tot), __float_as_uint(tot), false, false); tot = __uint_as_float(rr[0]); }
    bf16x8 kf[4][3];
    const int swz = r32 & 15;
#define AT_KLOAD(ds_) do { const int off_ = r32 * 256 + (((2 * (ds_) + hi) ^ swz) << 4); \
        if constexpr (LITE & 4) { kf[(ds_) & 3][0] = ntri[0]; kf[(ds_) & 3][1] = ntri[1]; kf[(ds_) & 3][2] = none; } else { \
        kf[(ds_) & 3][0] = *(const LAS bf16x8*)(Kt + off_); kf[(ds_) & 3][1] = *(const LAS bf16x8*)(Kt + off_ + 32 * 256); kf[(ds_) & 3][2] = *(const LAS bf16x8*)(Qs + off_); } } while (0)
    if constexpr (QK) {
#pragma unroll
        for (int r = 0; r < 16; ++r) { zN0[r] = 0.f; zN1[r] = 0.f; }
        AT_KLOAD(0); AT_KLOAD(1); AT_KLOAD(2);
    }
#pragma unroll
    for (int ds = 0; ds < 8; ++ds) {
        if constexpr (QK) {
            if (ds + 3 < 8) AT_KLOAD(ds + 3);
            if constexpr (LITE & 8) { zN0[ds] += __builtin_bit_cast(f32x4, kf[ds & 3][0])[0] * __builtin_bit_cast(f32x4, kf[ds & 3][2])[1]; zN1[ds] += __builtin_bit_cast(f32x4, kf[ds & 3][1])[2] * __builtin_bit_cast(f32x4, kf[ds & 3][2])[3]; } else {
            zN0 = __builtin_amdgcn_mfma_f32_32x32x16_bf16(kf[ds & 3][0], kf[ds & 3][2], zN0, 0, 0, 0);
            zN1 = __builtin_amdgcn_mfma_f32_32x32x16_bf16(kf[ds & 3][1], kf[ds & 3][2], zN1, 0, 0, 0); }
        }
        if constexpr (PV) {
            const int r = 2 * ds;
            float a0 = ex2<LITE>(a.y0[r] + a.R), a1 = ex2<LITE>(a.y0[r + 1] + a.R), b0 = ex2<LITE>(a.y1[r] + a.R), b1 = ex2<LITE>(a.y1[r + 1] + a.R);
            if constexpr (DPV) { const int k0 = crow(r, hi), k1 = crow(r + 1, hi);
                a0 = (k0 < qrelPV) ? a0 : 0.f; a1 = (k1 < qrelPV) ? a1 : 0.f; b0 = (k0 + 32 < qrelPV) ? b0 : 0.f; b1 = (k1 + 32 < qrelPV) ? b1 : 0.f; }
            pw[r >> 3][(r >> 1) & 3] = pg8::cvt_pk_bf16(a0, a1); pw[2 + (r >> 3)][(r >> 1) & 3] = pg8::cvt_pk_bf16(b0, b1);
        }
        __builtin_amdgcn_sched_barrier(0);
    }
#undef AT_KLOAD
    if constexpr (PV) a.R += tot;
    const LAS unsigned char* vb = Vt + ((lane >> 4) & 1) * 32 + (lane & 3) * 8 + (4 * hi + ((lane & 15) >> 2)) * 64;
    s16x4 vl[4], vh[4];
#define AT_VLOAD(i_) do { if constexpr (LITE & 4) { vl[(i_) & 3] = (s16x4){ntri[0][0], ntri[0][1], ntri[0][2], ntri[0][3]}; vh[(i_) & 3] = (s16x4){ntri[1][4], ntri[1][5], ntri[1][6], ntri[1][7]}; } else { \
        vl[(i_) & 3] = vtr(vb + ((i_) >> 2) * 4096 + ((i_) & 3) * 1024); vh[(i_) & 3] = vtr(vb + ((i_) >> 2) * 4096 + ((i_) & 3) * 1024 + 512); } } while (0)
    if constexpr (PV) { AT_VLOAD(0); AT_VLOAD(1); AT_VLOAD(2); }
    float zfirst = 0.f;
#pragma unroll
    for (int i = 0; i < 16; ++i) {
        const int d = i >> 2, ks = i & 3;
        if constexpr (PV) {
            if (i + 3 < 16) AT_VLOAD(i + 3);
            const s16x4 lo = vl[i & 3], hh = vh[i & 3];
            const bf16x8 vf = (bf16x8){lo[0], lo[1], lo[2], lo[3], hh[0], hh[1], hh[2], hh[3]};
            if constexpr (LITE & 8) a.o[d][i & 15] += __builtin_bit_cast(f32x4, vf)[0] * __uint_as_float(pw[ks][i & 3]); else
            a.o[d] = __builtin_amdgcn_mfma_f32_32x32x16_bf16(__builtin_bit_cast(bf16x8, pw[ks]), vf, a.o[d], 0, 0, 0);
        }
        if constexpr (QK) {
            if (i == 0) zfirst = zN0[0];
            if (i < 8) { const int r = 2 * i;
                float z0 = zN0[r], z1 = zN0[r + 1]; asm volatile("" : "+v"(z0), "+v"(z1));
                float s0 = vmaxf(z0, 0.f) + sp_tail<LITE>(z0), s1 = vmaxf(z1, 0.f) + sp_tail<LITE>(z1);
                if constexpr (DQK) { s0 = (crow(r, hi) < qrelQK) ? s0 : 0.f; s1 = (crow(r + 1, hi) < qrelQK) ? s1 : 0.f; }
                z0 -= s0; z1 -= s1;
                unsigned xp = pg8::cvt_pk_bf16(s0, s1); asm volatile("" : "+v"(z0), "+v"(z1), "+v"(xp));
                zN0[r] = z0; zN0[r + 1] = z1; xw[r >> 3][(r >> 1) & 3] = xp;
            } else { const int r = 2 * (i - 8);
                float z0 = zN1[r], z1 = zN1[r + 1]; asm volatile("" : "+v"(z0), "+v"(z1));
                float s0 = vmaxf(z0, 0.f) + sp_tail<LITE>(z0), s1 = vmaxf(z1, 0.f) + sp_tail<LITE>(z1);
                if constexpr (DQK) { s0 = (crow(r, hi) + 32 < qrelQK) ? s0 : 0.f; s1 = (crow(r + 1, hi) + 32 < qrelQK) ? s1 : 0.f; }
                z0 -= s0; z1 -= s1;
                unsigned xp = pg8::cvt_pk_bf16(s0, s1); asm volatile("" : "+v"(z0), "+v"(z1), "+v"(xp));
                zN1[r] = z0; zN1[r + 1] = z1; xw[2 + (r >> 3)][(r >> 1) & 3] = xp;
            }
        }
        __builtin_amdgcn_sched_barrier(0);
    }
#undef AT_VLOAD
    if constexpr (QK) {
        const bf16x8 x00 = __builtin_bit_cast(bf16x8, xw[0]), x01 = __builtin_bit_cast(bf16x8, xw[1]), x10 = __builtin_bit_cast(bf16x8, xw[2]), x11 = __builtin_bit_cast(bf16x8, xw[3]);
        zN0 = __builtin_amdgcn_mfma_f32_32x32x16_bf16(ntri[0], x00, zN0, 0, 0, 0);
        zN1 = __builtin_amdgcn_mfma_f32_32x32x16_bf16(ntri[0], x10, zN1, 0, 0, 0);
        zN0 = __builtin_amdgcn_mfma_f32_32x32x16_bf16(ntri[1], x01, zN0, 0, 0, 0);
        zN1 = __builtin_amdgcn_mfma_f32_32x32x16_bf16(ntri[1], x11, zN1, 0, 0, 0);
        zN0 = __builtin_amdgcn_mfma_f32_32x32x16_bf16(none, x10, zN0, 0, 0, 0);
        zN0 = __builtin_amdgcn_mfma_f32_32x32x16_bf16(none, x11, zN0, 0, 0, 0);
        a.y0 = zN0; a.y1 = zN1; a.zf = zfirst;
    }
}

template <int LITE = 0>
__device__ __forceinline__ void attn_unit(LAS unsigned char* lds, int b, int h, int qb, const bf16_t* Qb, const bf16_t* Kb, const bf16_t* Vb, const bf16_t* SG, bf16_t* OG, int tid_in) {
    int tid = tid_in; asm volatile("" : "+v"(tid));
    const int lane = tid & 63, wid = __builtin_amdgcn_readfirstlane(tid >> 6), r32 = lane & 31, hi = lane >> 5;
    const size_t rowbase = (size_t)b * SEQ;
    const int R0 = 256 * qb + 32 * wid;
    const int NT = 4 * qb + 4, jd = 4 * qb + (wid >> 1);
    LAS unsigned char* Qs = lds + AT_Q + wid * 8192;
#pragma unroll
    for (int i = 0; i < 8; ++i) { const int p = lane + 64 * i, row = p >> 4, ch = p & 15;
        *(LAS u32x4*)(Qs + row * 256 + ((ch ^ (row & 15)) << 4)) = *(const u32x4*)(Qb + (rowbase + R0 + row) * D_MODEL + h * HEAD_DIM + ch * 8); }
    bf16x8 ntri[2], none;
#pragma unroll
    for (int s = 0; s < 2; ++s)
#pragma unroll
        for (int e = 0; e < 8; ++e) { const int j = 16 * s + 8 * (e >> 2) + 4 * hi + (e & 3); ntri[s][e] = (j > r32) ? (short)0xBF80 : (short)0; }
#pragma unroll
    for (int e = 0; e < 8; ++e) none[e] = (short)0xBF80;
    AttnRegs a;
#pragma unroll
    for (int d = 0; d < 4; ++d)
#pragma unroll
        for (int r = 0; r < 16; ++r) a.o[d][r] = 0.f;
#pragma unroll
    for (int r = 0; r < 16; ++r) { a.y0[r] = 0.f; a.y1[r] = 0.f; }
    a.R = 0.f; a.zf = 0.f;
    const bf16_t* Kh = Kb + rowbase * D_MODEL + h * HEAD_DIM; const bf16_t* Vh = Vb + rowbase * D_MODEL + h * HEAD_DIM;
    const bf16_t* ksrc[2]; const bf16_t* vsrc[2];
#pragma unroll
    for (int i = 0; i < 2; ++i) { const int pi = 2 * wid + i, key = 4 * pi + (lane >> 4), c = (lane & 15) ^ (key & 15);
        ksrc[i] = Kh + (size_t)key * D_MODEL + c * 8;
        const int vkey = 16 * (pi & 3) + (lane >> 2);
        vsrc[i] = Vh + (size_t)vkey * D_MODEL + (pi >> 2) * 32 + (lane & 3) * 8; }
    const unsigned ldsbase = (unsigned)(size_t)lds;
#define AT_GLDS(src_, dst_) do { unsigned keep_; asm volatile("s_mov_b32 %0, m0\n\ts_mov_b32 m0, %2\n\ts_nop 0\n\tglobal_load_lds_dwordx4 %1, off\n\ts_mov_b32 m0, %0" : "=&s"(keep_) : "v"(src_), "s"(dst_) : "memory"); } while (0)
#define AT_DMA_K(jt_, slot_) do { _Pragma("unroll") for (int i_ = 0; i_ < 2; ++i_) \
        AT_GLDS(ksrc[i_] + (size_t)(jt_) * 64 * D_MODEL, (unsigned)__builtin_amdgcn_readfirstlane(ldsbase + AT_K + (slot_) * AT_KV_BYTES + (2 * wid + i_) * 1024)); } while (0)
#define AT_DMA_V(jt_, slot_) do { _Pragma("unroll") for (int i_ = 0; i_ < 2; ++i_) \
        AT_GLDS(vsrc[i_] + (size_t)(jt_) * 64 * D_MODEL, (unsigned)__builtin_amdgcn_readfirstlane(ldsbase + AT_V + (slot_) * AT_KV_BYTES + (2 * wid + i_) * 1024)); } while (0)
#define AT_WAIT_BAR() do { asm volatile("s_waitcnt vmcnt(0) lgkmcnt(0)" ::: "memory"); __builtin_amdgcn_s_barrier(); asm volatile("" ::: "memory"); } while (0)
    AT_DMA_K(NT - 1, (NT - 1) & 1);
    AT_WAIT_BAR();
#define AT_PRE(t_) do { if constexpr (!(LITE & 16)) { if ((t_) >= 2) AT_DMA_K((t_) - 2, (t_) & 1); if ((t_) >= 1) AT_DMA_V((t_) - 1, ((t_) - 1) & 1); } } while (0)
#define AT_KT(t_) (lds + AT_K + (((t_) - 1) & 1) * AT_KV_BYTES)
#define AT_VT(t_) (lds + AT_V + ((t_) & 1) * AT_KV_BYTES)
    int t = NT;
#pragma unroll 1
    for (; t > jd + 1; --t) { AT_PRE(t); AT_WAIT_BAR(); }
    { AT_PRE(t);
      if constexpr (!(LITE & 2)) attn_step<true, true, true, true, LITE>(a, AT_KT(t), AT_VT(t), Qs, lane, R0 - 64 * (t - 1) + r32, -(1 << 20), ntri, none);
      AT_WAIT_BAR(); --t; }
    { AT_PRE(t);
      if constexpr (!(LITE & 2)) attn_step<true, true, true, true, LITE>(a, AT_KT(t), AT_VT(t), Qs, lane, 1 << 20, R0 - 64 * t + r32, ntri, none);
      AT_WAIT_BAR(); --t; }
#pragma unroll 1
    for (; t >= 0; --t) { AT_PRE(t);
      if constexpr (!(LITE & 2)) attn_step<true, true, false, false, LITE>(a, AT_KT(t), AT_VT(t), Qs, lane, 0, 0, ntri, none);
      AT_WAIT_BAR(); }
#undef AT_PRE
#undef AT_KT
#undef AT_VT
#undef AT_DMA_K
#undef AT_GLDS
#undef AT_DMA_V
#undef AT_WAIT_BAR
#pragma unroll
    for (int r = 0; r < 16; ++r) { const size_t rowoff = (rowbase + R0 + crow(r, hi)) * D_MODEL + h * HEAD_DIM + r32;
#pragma unroll
        for (int d = 0; d < 4; ++d) { const float gsv = __uint_as_float((unsigned)SG[rowoff + d * 32] << 16); OG[rowoff + d * 32] = (bf16_t)f2bf(a.o[d][r] * gsv); } }
}

__global__ void __launch_bounds__(NWAVES * 64, 2) yoco_fwd(Args args) {
    extern __shared__ __attribute__((aligned(16))) unsigned char lds_raw[];
    LAS unsigned char* lds = (LAS unsigned char*)lds_raw;
    volatile LAS unsigned* MISC = (volatile LAS unsigned*)(lds + MISC_OFF);
    const int tid = threadIdx.x, lane = tid & 63, wave = __builtin_amdgcn_readfirstlane(tid >> 6);
    const int G = gridDim.x; const int bx = blockIdx.x; const int vcu = (G % 8 == 0) ? (bx % 8) * (G / 8) + bx / 8 : bx;
    unsigned char* ws = args.ws;
    gu32* ctl = (gu32*)(ws + WS_CTL);
    for (int u = tid; u < (LDS_BYTES - LDSCTL_OFF) / 4; u += NWAVES * 64) ((LAS unsigned*)(lds + LDSCTL_OFF))[u] = 0u;
    __syncthreads();
    XcdBarrier bar = xcd_barrier_post((unsigned*)(ctl + CW_BAR), MISC + 8);
#define GRID_BAR() do { for (int rep_ = 0; rep_ < DUP_BAR; ++rep_) xcd_barrier(bar); } while (0)

    float* rowss = (float*)(ws + WS_ROWSS); float* lnst = (float*)(ws + WS_LNST);
    bf16_t* WIN = (bf16_t*)(ws + WS_WIN); bf16_t* WOUT = (bf16_t*)(ws + WS_WOUT); bf16_t* WKVQ = (bf16_t*)(ws + WS_WKVQ); bf16_t* WQ3 = (bf16_t*)(ws + WS_WQ3);
    bf16_t* WBO = (bf16_t*)(ws + WS_WBO); bf16_t* WG = (bf16_t*)(ws + WS_WG); bf16_t* WP = (bf16_t*)(ws + WS_WP);
    bf16_t* PB = (bf16_t*)(ws + WS_PB); bf16_t* HB0 = (bf16_t*)(ws + WS_HB0);
    bf16_t* UG = (bf16_t*)(ws + WS_UG); bf16_t* GV = (bf16_t*)(ws + WS_GV);
    bf16_t* KB = (bf16_t*)(ws + WS_K); bf16_t* VB = (bf16_t*)(ws + WS_V); bf16_t* QB = (bf16_t*)(ws + WS_Q); bf16_t* SGB = (bf16_t*)(ws + WS_SG);
    bf16_t* OGB = (bf16_t*)args.out;

    for (int rep0 = 0; rep0 < DUP_P0; ++rep0) {
        int lane_p0 = tid & 63; asm volatile("" : "+v"(lane_p0)); const int lane = lane_p0;
        LAS float* scr = (LAS float*)(lds + wave * 16384);
        const int gw = vcu * NWAVES + wave, NGW = G * NWAVES; int jbase = 0;
        for (int i = 0; i < 2; ++i) TJOB(args.a_w_in + (size_t)i * D_MODEL * 6144, D_MODEL, 6144, 6144, 1, 0, args.norm_g + i * D_MODEL, WIN + (size_t)i * 6144 * D_MODEL);
        for (int i = 0; i < 2; ++i) TJOB(args.a_w_out + (size_t)i * A_WIDTH * D_MODEL, A_WIDTH, D_MODEL, D_MODEL, 0, 0, (const float*)nullptr, WOUT + (size_t)i * D_MODEL * A_WIDTH);
        TJOB(args.w_kv, D_MODEL, 2048, 2048, 0, 0, args.kv_norm_g, WKVQ);
        TJOB(args.b_w_in, D_MODEL, 2048, 2048, 0, 0, args.norm_g + 2 * D_MODEL, WKVQ + (size_t)2048 * D_MODEL);
        TJOB(args.b_w_in + (size_t)D_MODEL * 2048, D_MODEL, 2048, 2048, 0, 0, args.norm_g + 3 * D_MODEL, WQ3);
        for (int i = 0; i < 2; ++i) TJOB(args.b_w_out + (size_t)i * D_MODEL * D_MODEL, D_MODEL, D_MODEL, D_MODEL, 0, 0, (const float*)nullptr, WBO + (size_t)i * D_MODEL * D_MODEL);
        for (int i = 0; i < 4; ++i) TJOB(args.ple_gate_w + (size_t)i * D_MODEL * D_MODEL, D_MODEL, D_MODEL, D_MODEL, 0, 0, (const float*)nullptr, WG + (size_t)i * D_MODEL * D_MODEL);
        for (int i = 0; i < 4; ++i) TJOB(args.ple_w + (size_t)i * PLE_DIM * D_MODEL, PLE_DIM, D_MODEL, D_MODEL, 0, 0, (const float*)nullptr, WP + (size_t)i * D_MODEL * PLE_DIM);
        for (int m = gw; m < M; m += 2 * NGW) {
            const int m2 = m + NGW;
            const f32x4* xr = (const f32x4*)(args.x + (size_t)m * D_MODEL) + 2 * lane; const f32x4* xr2 = (const f32x4*)(args.x + (size_t)m2 * D_MODEL) + 2 * lane;
            f32x4 va[4], vb[4];
#pragma unroll
            for (int j = 0; j < 2; ++j) { va[2 * j] = xr[128 * j]; va[2 * j + 1] = xr[128 * j + 1]; vb[2 * j] = xr2[128 * j]; vb[2 * j + 1] = xr2[128 * j + 1]; }
            float s = 0.f, s2 = 0.f;
#pragma unroll
            for (int j = 0; j < 4; ++j) { s += (va[j][0] * va[j][0] + va[j][1] * va[j][1]) + (va[j][2] * va[j][2] + va[j][3] * va[j][3]); s2 += (vb[j][0] * vb[j][0] + vb[j][1] * vb[j][1]) + (vb[j][2] * vb[j][2] + vb[j][3] * vb[j][3]); }
#pragma unroll
            for (int j = 0; j < 2; ++j) {
                u32x4 o; o.x = pk2(va[2 * j][0], va[2 * j][1]); o.y = pk2(va[2 * j][2], va[2 * j][3]); o.z = pk2(va[2 * j + 1][0], va[2 * j + 1][1]); o.w = pk2(va[2 * j + 1][2], va[2 * j + 1][3]);
                pg8::st16_wt(HB0 + (size_t)m * D_MODEL + 512 * j + 8 * lane, o);
                o.x = pk2(vb[2 * j][0], vb[2 * j][1]); o.y = pk2(vb[2 * j][2], vb[2 * j][3]); o.z = pk2(vb[2 * j + 1][0], vb[2 * j + 1][1]); o.w = pk2(vb[2 * j + 1][2], vb[2 * j + 1][3]);
                pg8::st16_wt(HB0 + (size_t)m2 * D_MODEL + 512 * j + 8 * lane, o); }
            s = wave_sum(s); s2 = wave_sum(s2);
            if (lane < 16) { rowss[(size_t)m * 16 + lane] = (lane == 0) ? s : 0.f; rowss[(size_t)m2 * 16 + lane] = (lane == 0) ? s2 : 0.f; }
        }
        convert_p(args.p, PB, vcu * 512 + tid, G * 512);
    }
    GRID_BAR();

    for (int L = 0; L < DEPTH; ++L) {
        bf16_t* Ebuf = (L < N_A) ? (bf16_t*)(ws + WS_EA) : (bf16_t*)(ws + WS_EB);
        bf16_t* HB1 = (L < N_A) ? (bf16_t*)(ws + WS_HB1A) : (bf16_t*)(ws + WS_HB1B);
        if (L < N_A) {
            { pg8::Gemm g{HB0, WIN + (size_t)L * 6144 * D_MODEL, M, 6144, D_MODEL}; pg8::StaticOrder S; S.init(M, 6144, G, bx);
              pg8::EpiA1 E{UG, GV, lnst, rowss};
              for (int rep = 0; rep < DUP_A1; ++rep) pg8::gemm_phase<pg8::EpiA1, pg8::StaticOrder, true, true>(lds, g, S, E); }
            GRID_BAR();
            if (L > 0) convert_p(args.p + (size_t)L * M * PLE_DIM, PB, vcu * 512 + tid, G * 512);
            if (G == 256) for (int rep = 0; rep < DUP_MIX; ++rep)
                mix_phase(lds, vcu, args.a_w_s + (size_t)L * A_GROUPS * 128 * 128, args.a_b_s + (size_t)L * A_GROUPS * 128, args.a_ln_g + (size_t)L * A_WIDTH, args.a_ln_b + (size_t)L * A_WIDTH,
                          GV, UG, rep + 1 < DUP_MIX ? OGB : UG, rep + 1 < DUP_MIX ? (size_t)(16u * MiB - 1) : ~(size_t)0, lnst, tid);
            GRID_BAR();
            { pg8::Gemm g{UG, WOUT + (size_t)L * D_MODEL * A_WIDTH, M, D_MODEL, A_WIDTH}; pg8::StaticOrder S; S.init(M, D_MODEL, G, bx);
              pg8::EpiMix E{HB0, HB1};
              for (int rep = 0; rep < DUP_MIXG; ++rep) pg8::gemm_phase<pg8::EpiMix, pg8::StaticOrder, true, true>(lds, g, S, E); }
        } else {
            const int j = L - N_A;
            { pg8::Gemm g{HB0, j == 0 ? WKVQ : WQ3, M, j == 0 ? 4096 : 2048, D_MODEL}; pg8::StaticOrder S; S.init(M, g.N, G, bx);
              pg8::EpiKVQ E{KB, VB, QB, SGB, rowss, j == 0 ? 0 : 2};
              for (int rep = 0; rep < DUP_KVQ; ++rep) pg8::gemm_phase<pg8::EpiKVQ, pg8::StaticOrder, true, true>(lds, g, S, E); }
            GRID_BAR();
            convert_p(args.p + (size_t)L * M * PLE_DIM, PB, vcu * 512 + tid, G * 512);
            { const int xg = vcu >> 5, l = vcu & 31, bh1 = 8 * xg + (l >> 3), bh2 = bh1 + 4, q1 = l & 7, q2 = 7 - q1;
              if (G == 256) {
                  for (int rep = 1; rep < DUP_ATTN; ++rep) {
                  attn_unit<DUP_LITE>(lds, bh1 >> 3, bh1 & 7, q1, QB, KB, VB, SGB, OGB + (size_t)M * D_MODEL, tid);
                  attn_unit<DUP_LITE>(lds, bh2 >> 3, bh2 & 7, q2, QB, KB, VB, SGB, OGB + (size_t)M * D_MODEL, tid); }
                  attn_unit(lds, bh1 >> 3, bh1 & 7, q1, QB, KB, VB, SGB, OGB, tid);
                  attn_unit(lds, bh2 >> 3, bh2 & 7, q2, QB, KB, VB, SGB, OGB, tid);
              } }
            GRID_BAR();
            { pg8::Gemm g{OGB, WBO + (size_t)j * D_MODEL * D_MODEL, M, D_MODEL, D_MODEL}; pg8::StaticOrder S; S.init(M, D_MODEL, G, bx);
              pg8::EpiMix E{HB0, HB1};
              for (int rep = 0; rep < DUP_MIXG; ++rep) pg8::gemm_phase<pg8::EpiMix, pg8::StaticOrder, true, true>(lds, g, S, E); }
        }
        { pg8::Gemm g{PB, WP + (size_t)L * D_MODEL * PLE_DIM, M, D_MODEL, PLE_DIM}; pg8::StaticOrder S; S.init(M, D_MODEL, G, bx);
          pg8::EpiE E{Ebuf};
          for (int rep = 0; rep < DUP_E; ++rep) pg8::gemm_phase<pg8::EpiE, pg8::StaticOrder, true, true>(lds, g, S, E); }
        GRID_BAR();
        { pg8::Gemm g{HB1, WG + (size_t)L * D_MODEL * D_MODEL, M, D_MODEL, D_MODEL}; pg8::StaticOrder S; S.init(M, D_MODEL, G, bx);
          pg8::EpiPle E{HB1, Ebuf, HB0, rowss};
          for (int rep = 0; rep < DUP_PLE; ++rep) pg8::gemm_phase<pg8::EpiPle, pg8::StaticOrder, true, true>(lds, g, S, E); }
        GRID_BAR();
    }
    {
        int lane_fn = tid & 63; asm volatile("" : "+v"(lane_fn)); const int lane = lane_fn;
        const int gw = vcu * NWAVES + wave, NGW = G * NWAVES;
        f32x4 gv[4];
#pragma unroll
        for (int j = 0; j < 4; ++j) gv[j] = *((const f32x4*)args.final_g + lane + 64 * j);
        for (int m = gw; m < M; m += NGW) {
            const u32x2* hr = (const u32x2*)(HB0 + (size_t)m * D_MODEL) + lane; f32x4* orow = (f32x4*)(args.out + (size_t)m * D_MODEL) + lane; f32x4 v[4]; float s = 0.f;
#pragma unroll
            for (int j = 0; j < 4; ++j) { const u32x2 w = hr[64 * j]; v[j] = (f32x4){bflo(w.x), bfhi(w.x), bflo(w.y), bfhi(w.y)}; s += (v[j][0] * v[j][0] + v[j][1] * v[j][1]) + (v[j][2] * v[j][2] + v[j][3] * v[j][3]); }
            const float rstd = 1.0f / sqrtf(wave_sum(s) * (1.0f / D_MODEL) + EPS);
#pragma unroll
            for (int j = 0; j < 4; ++j) orow[64 * j] = v[j] * rstd * gv[j];
        }
    }
}

extern "C" void kernel_launch(void* const* d_in, const int* in_sizes, int n_in, void* d_out, int out_size, void* d_ws, size_t ws_size, hipStream_t stream) {
    static int grid = 0;
    if (grid == 0) {
        if (n_in != 16 || in_sizes[0] != M * D_MODEL || out_size != M * D_MODEL || ws_size < WS_END) { fprintf(stderr, "kernel_launch: unexpected shapes (n_in %d, ws %zu); nothing launched\n", n_in, ws_size); grid = -1; return; }
        int dev = 0, cus = 0, per_cu = 0;
        if (hipGetDevice(&dev) != hipSuccess || hipDeviceGetAttribute(&cus, hipDeviceAttributeMultiprocessorCount, dev) != hipSuccess) { grid = -1; return; }
        if (hipFuncSetAttribute((const void*)yoco_fwd, hipFuncAttributeMaxDynamicSharedMemorySize, LDS_BYTES) != hipSuccess) { fprintf(stderr, "kernel_launch: hipFuncSetAttribute failed\n"); grid = -1; return; }
        if (hipOccupancyMaxActiveBlocksPerMultiprocessor(&per_cu, (const void*)yoco_fwd, NWAVES * 64, LDS_BYTES) != hipSuccess || per_cu < 1) { fprintf(stderr, "kernel_launch: occupancy query says %d blocks per CU\n", per_cu); per_cu = 1; }
        (void)hipGetLastError();
        grid = cus * 1;
    }
    if (grid < 0) return;
    (void)hipMemsetAsync((char*)d_ws + WS_CTL, 0, CTL_ZERO_BYTES, stream);
    Args a{};
    a.x = (const float*)d_in[0]; a.p = (const float*)d_in[1]; a.norm_g = (const float*)d_in[2]; a.a_w_in = (const float*)d_in[3]; a.a_ln_g = (const float*)d_in[4]; a.a_ln_b = (const float*)d_in[5];
    a.a_w_s = (const float*)d_in[6]; a.a_b_s = (const float*)d_in[7]; a.a_w_out = (const float*)d_in[8]; a.kv_norm_g = (const float*)d_in[9]; a.w_kv = (const float*)d_in[10]; a.b_w_in = (const float*)d_in[11];
    a.b_w_out = (const float*)d_in[12]; a.ple_w = (const float*)d_in[13]; a.ple_gate_w = (const float*)d_in[14]; a.final_g = (const float*)d_in[15];
    a.out = (float*)d_out; a.ws = (unsigned char*)d_ws;
    void* kargs[] = {&a};
    hipError_t e = hipLaunchCooperativeKernel((const void*)yoco_fwd, dim3(grid), dim3(NWAVES * 64), kargs, LDS_BYTES, stream);
    if (e != hipSuccess) fprintf(stderr, "kernel_launch: cooperative launch failed: %s (grid %d)\n", hipGetErrorString(e), grid);
}
```

```cpp
#include <hip/hip_runtime.h>
#include <hip/hip_cooperative_groups.h>
#include <cstdio>
#include <cstdint>

#define LAS __attribute__((address_space(3)))
#define GAS __attribute__((address_space(1)))
typedef unsigned short bf16_t;
typedef short bf16x8 __attribute__((ext_vector_type(8)));
typedef short s16x4 __attribute__((ext_vector_type(4)));
typedef float f32x4 __attribute__((ext_vector_type(4)));
typedef float f32x2 __attribute__((ext_vector_type(2)));
typedef float f32x16 __attribute__((ext_vector_type(16)));
typedef unsigned u32x4 __attribute__((ext_vector_type(4)));
typedef unsigned u32x2 __attribute__((ext_vector_type(2)));

#define DUP_ATTN 1
#define DUP_LITE 0
#define DUP_A1 1
#define DUP_KVQ 1
#define DUP_E 1
#define DUP_P0 1
#define DUP_BAR 1
#define DUP_MIX 1
#define DUP_MIXG 1
#define DUP_PLE 1
#define PROBE_ID 0
#define STAGGER_TICKS 0u
#define PB_WORD(lds_) ((volatile LAS unsigned*)((lds_) + MISC_OFF + 64))
#define PB_BEGIN(id_) unsigned long long pbt_##id_ = 0; if (PROBE_ID == (id_)) { __builtin_amdgcn_sched_barrier(0); pbt_##id_ = __builtin_amdgcn_s_memrealtime(); __builtin_amdgcn_sched_barrier(0); }
#define PB_END(id_, lds_, on_) if (PROBE_ID == (id_)) { __builtin_amdgcn_sched_barrier(0); const unsigned pbd_ = (unsigned)(__builtin_amdgcn_s_memrealtime() - pbt_##id_); __builtin_amdgcn_sched_barrier(0); if (on_) *PB_WORD(lds_) = *PB_WORD(lds_) + pbd_; }
constexpr int D_MODEL = 1024, BATCH = 8, SEQ = 2048, DEPTH = 4, N_A = 2, A_WIDTH = 2048, A_GROUPS = 8, B_HEADS = 8, HEAD_DIM = 128, PLE_DIM = 256;
constexpr int M = BATCH * SEQ;
constexpr float EPS = 1e-6f;
constexpr float LOG2E = 1.4426950408889634f;
constexpr float QSCALE = 0.08838834764831845f * LOG2E;

constexpr size_t MiB = 1u << 20;
constexpr size_t WS_CTL = 0, CTL_ZERO_BYTES = 64 * 1024;
constexpr size_t WS_ROWSS = 1 * MiB;
constexpr size_t WS_LNST = 2 * MiB;
constexpr size_t WS_WIN = 6 * MiB;
constexpr size_t WS_WOUT = 30 * MiB;
constexpr size_t WS_WKVQ = 38 * MiB;
constexpr size_t WS_WQ3 = 46 * MiB;
constexpr size_t WS_WBO = 50 * MiB;
constexpr size_t WS_WG = 54 * MiB;
constexpr size_t WS_WP = 62 * MiB;
constexpr size_t WS_PB = 64 * MiB;
constexpr size_t WS_HB0 = 72 * MiB;
constexpr size_t WS_REG = 104 * MiB;
constexpr size_t WS_UG = WS_REG, WS_GV = WS_REG + 64 * MiB;
constexpr size_t WS_K = WS_REG, WS_V = WS_REG + 32 * MiB, WS_Q = WS_REG + 64 * MiB, WS_SG = WS_REG + 96 * MiB;
constexpr size_t WS_EA = WS_GV, WS_HB1A = WS_GV + 32 * MiB;
constexpr size_t WS_EB = WS_SG, WS_HB1B = WS_WIN;
constexpr size_t WS_END = 232 * MiB;

constexpr int RING_BYTES = 131072;
constexpr int LDSCTL_OFF = RING_BYTES, MISC_OFF = LDSCTL_OFF + 320;
constexpr int LDS_BYTES = 155648;
constexpr int PFD_OFF = LDSCTL_OFF + 1024 + 8192;
constexpr int RSTD_OFF = LDSCTL_OFF + 1024;
constexpr int NWAVES = 8;

namespace pg8 {
constexpr int BM = 256, BK = 64, HALF = 128, HTB = HALF * BK * 2, STAGE_BYTES = 8 * HTB, NXCD = 8, WGM = 8;
__host__ __device__ __forceinline__ int lds_byte(int r, int c) { const int st = (r >> 4) * 2 + (c >> 5), rr = r & 15, cc = c & 31, ob = rr * 64 + cc * 2; return st * 1024 + (ob ^ (((ob >> 9) & 1) << 5)); }
__host__ __device__ __forceinline__ void stage_rc(int b, int& R, int& C) { const int st = b / 1024, sb = b % 1024, swz = sb ^ (((sb >> 9) & 1) << 5); R = (st >> 1) * 16 + swz / 64; C = (st & 1) * 32 + (swz % 64) / 2; }
__host__ __device__ __forceinline__ int perm32(int rho) { const int n = rho >> 4, i = rho & 15; return 8 * (i >> 2) + 4 * n + (i & 3); }

struct Unit { int pm, pn, ord; };
struct Gemm { const bf16_t* A; const bf16_t* Bt; int M, N, K; };

struct StaticOrder {
    int nM, nN, nwg, G, c;
    __host__ __device__ void init(int M_, int N_, int G_, int c_) { nM = M_ / BM; nN = N_ / BM; nwg = nM * nN; G = G_; c = c_; }
    __host__ __device__ bool next(int i, Unit& u) const {
        const long L = (long)i * G + c; if (L >= nwg) return false;
        int wgid = (int)L; { const int q = nwg / NXCD, r = nwg % NXCD, xcd = wgid % NXCD, off = wgid / NXCD; wgid = (xcd < r ? xcd * (q + 1) : r * (q + 1) + (xcd - r) * q) + off; }
        const int nig = WGM * nN, gid = wgid / nig, fm = gid * WGM, gsz = (nM - fm) < WGM ? (nM - fm) : WGM;
        u.pm = fm + ((wgid % nig) % gsz); u.pn = (wgid % nig) / gsz; u.ord = i; return true;
    }
    __device__ __forceinline__ void a_ready(const Unit&) const {}
    __device__ __forceinline__ void done(const Unit&) const {}
};

__device__ __forceinline__ unsigned cvt_pk_bf16(float lo, float hi) { unsigned r; asm volatile("v_cvt_pk_bf16_f32 %0, %1, %2" : "=v"(r) : "v"(lo), "v"(hi)); return r; }

__device__ __forceinline__ f32x2 gelu_pk(f32x2 v) {
    const f32x2 av = __builtin_elementwise_abs(v), d = av * 0.2316418882f + 1.0f;
    f32x2 t; t.x = __builtin_amdgcn_rcpf(d.x); t.y = __builtin_amdgcn_rcpf(d.y);
    f32x2 q = t * 0.5307027145f + (-0.7265760135f); q = q * t + 0.7107068705f; q = q * t + (-0.142248368f); q = q * t + 0.127414796f; q = q * t;
    const f32x2 s = (v * v) * (-0.72134752044f);
    f32x2 e; e.x = __builtin_amdgcn_exp2f(s.x); e.y = __builtin_amdgcn_exp2f(s.y);
    const f32x2 m = v * (q * e), r = v - m;
    f32x2 o; o.x = v.x < 0.f ? m.x : r.x; o.y = v.y < 0.f ? m.y : r.y; return o;
}
__device__ __forceinline__ f32x4 gelu4(f32x4 v) { const f32x2 a = gelu_pk((f32x2){v[0], v[1]}), b = gelu_pk((f32x2){v[2], v[3]}); return (f32x4){a.x, a.y, b.x, b.y}; }
__device__ __forceinline__ float sigmoid1(float x) { return __builtin_amdgcn_rcpf(1.0f + __builtin_amdgcn_exp2f(-LOG2E * x)); }
__device__ __forceinline__ f32x4 sigmoid4(f32x4 v) { return (f32x4){sigmoid1(v[0]), sigmoid1(v[1]), sigmoid1(v[2]), sigmoid1(v[3])}; }
__device__ __forceinline__ f32x4 silu4(f32x4 v) { return v * sigmoid4(v); }

__device__ __forceinline__ void load_rstd(const LAS float* tab, int ord, int wr, int fr, float (&rs)[2][4]) {
#pragma unroll
    for (int ai = 0; ai < 2; ++ai)
#pragma unroll
        for (int m = 0; m < 4; ++m) rs[ai][m] = tab[ord * 256 + ai * HALF + wr * 64 + m * 16 + fr];
}
template <class Sched>
__device__ __forceinline__ void fill_rstd(LAS unsigned char* lds, const float* rowss, const Sched& S, int tid_in) {
    LAS float* tab = (LAS float*)(lds + RSTD_OFF);
    int tid = tid_in; asm volatile("" : "+v"(tid));
    Unit u;
#pragma unroll 1
    for (int i = 0; i < 8 && S.next(i, u); ++i)
        if (tid < 256) { const f32x4* p = (const f32x4*)(rowss + (size_t)(u.pm * BM + tid) * 16); const f32x4 a = p[0], b = p[1], c = p[2], d = p[3];
            const float s = ((a[0] + a[1]) + (a[2] + a[3])) + ((b[0] + b[1]) + (b[2] + b[3])) + ((c[0] + c[1]) + (c[2] + c[3])) + ((d[0] + d[1]) + (d[2] + d[3]));
            tab[i * 256 + tid] = 1.0f / sqrtf(s * (1.0f / D_MODEL) + EPS); }
    asm volatile("s_waitcnt lgkmcnt(0)" ::: "memory");
}
__device__ __forceinline__ u32x4 pack8(f32x4 v0, f32x4 v1) { u32x4 w; w.x = cvt_pk_bf16(v0[0], v0[1]); w.y = cvt_pk_bf16(v0[2], v0[3]); w.z = cvt_pk_bf16(v1[0], v1[1]); w.w = cvt_pk_bf16(v1[2], v1[3]); return w; }
__device__ __forceinline__ void st16_wt(void* p, u32x4 v) { asm volatile("global_store_dwordx4 %0, %1, off sc1\n\ts_nop 1" :: "v"(p), "v"(v) : "memory"); }
__device__ __forceinline__ u32x2 pack4(f32x4 v0) { u32x2 w; w.x = cvt_pk_bf16(v0[0], v0[1]); w.y = cvt_pk_bf16(v0[2], v0[3]); return w; }

struct EpiA1 {
    static constexpr bool PERM = true, AFTER_DRAIN = false; static constexpr int PBID = 31;
    bf16_t* UG; bf16_t* GV; float* lnst; const LAS float* rtab;
    __device__ __forceinline__ void operator()(const f32x4 (&acc)[2][2][4][2], const Unit& u, int wr, int wc, int fr, int fq) const {
        const int row0 = u.pm * BM + wr * 64 + fr;
        float rs[2][4]; load_rstd(rtab, u.ord, wr, fr, rs);
        if (u.pn < 16) {
            const int ch0 = u.pn * 128 + wc * 32 + 8 * fq;
#pragma unroll
            for (int ai = 0; ai < 2; ++ai)
#pragma unroll
                for (int m = 0; m < 4; ++m) {
                    const float r = rs[ai][m]; const int row = row0 + ai * HALF + m * 16;
                    const f32x4 u0 = gelu4(acc[ai][0][m][0] * r), u1 = gelu4(acc[ai][0][m][1] * r);
                    const f32x4 g0 = silu4(acc[ai][1][m][0] * r), g1 = silu4(acc[ai][1][m][1] * r);
                    st16_wt(UG + (size_t)row * A_WIDTH + ch0, pack8(u0 * g0, u1 * g1));
                }
        } else {
            const int g = u.pn - 16, ch0 = g * 256 + wc * 32 + 8 * fq;
#pragma unroll
            for (int ai = 0; ai < 2; ++ai)
#pragma unroll
                for (int m = 0; m < 4; ++m) {
                    const float r = rs[ai][m]; const int row = row0 + ai * HALF + m * 16;
                    float s1 = 0.f, s2 = 0.f;
#pragma unroll
                    for (int bj = 0; bj < 2; ++bj) {
                        const f32x4 v0 = gelu4(acc[ai][bj][m][0] * r), v1 = gelu4(acc[ai][bj][m][1] * r);
                        st16_wt(GV + (size_t)row * A_WIDTH + ch0 + bj * HALF, pack8(v0, v1));
                        s1 += ((v0[0] + v0[1]) + (v0[2] + v0[3])) + ((v1[0] + v1[1]) + (v1[2] + v1[3]));
                        s2 += ((v0[0] * v0[0] + v0[1] * v0[1]) + (v0[2] * v0[2] + v0[3] * v0[3])) + ((v1[0] * v1[0] + v1[1] * v1[1]) + (v1[2] * v1[2] + v1[3] * v1[3]));
                    }
                    s1 += __shfl_xor(s1, 16); s1 += __shfl_xor(s1, 32); s2 += __shfl_xor(s2, 16); s2 += __shfl_xor(s2, 32);
                    if (fq == 0) *(f32x2*)(lnst + ((size_t)row * 32 + g * 4 + wc) * 2) = (f32x2){s1, s2};
                }
        }
    }
};
struct EpiKVQ {
    static constexpr bool PERM = true, AFTER_DRAIN = false; static constexpr int PBID = 32;
    bf16_t* Kb; bf16_t* Vb; bf16_t* Qb; bf16_t* SG; const LAS float* rtab; int kind0;
    __device__ __forceinline__ void operator()(const f32x4 (&acc)[2][2][4][2], const Unit& u, int wr, int wc, int fr, int fq) const {
        const int row0 = u.pm * BM + wr * 64 + fr;
        float rs[2][4]; load_rstd(rtab, u.ord, wr, fr, rs);
        const int kind = kind0 + (u.pn >> 2);
        bf16_t* base = kind == 0 ? Kb : kind == 1 ? Vb : kind == 2 ? Qb : SG;
        const int col0 = (u.pn & 3) * 256 + wc * 32 + 8 * fq;
#pragma unroll
        for (int ai = 0; ai < 2; ++ai)
#pragma unroll
            for (int m = 0; m < 4; ++m) {
                float r = rs[ai][m]; if (kind == 2) r *= QSCALE; const int row = row0 + ai * HALF + m * 16;
#pragma unroll
                for (int bj = 0; bj < 2; ++bj) {
                    f32x4 v0 = acc[ai][bj][m][0] * r, v1 = acc[ai][bj][m][1] * r;
                    if (kind == 3) { v0 = silu4(v0); v1 = silu4(v1); }
                    st16_wt(base + (size_t)row * D_MODEL + col0 + bj * HALF, pack8(v0, v1));
                }
            }
    }
};
struct EpiE {
    static constexpr bool PERM = true, AFTER_DRAIN = false; static constexpr int PBID = 33;
    bf16_t* E;
    __device__ __forceinline__ void operator()(const f32x4 (&acc)[2][2][4][2], const Unit& u, int wr, int wc, int fr, int fq) const {
        const int row0 = u.pm * BM + wr * 64 + fr, col0 = u.pn * BM + wc * 32 + 8 * fq;
#pragma unroll
        for (int ai = 0; ai < 2; ++ai)
#pragma unroll
            for (int m = 0; m < 4; ++m) { const int row = row0 + ai * HALF + m * 16;
#pragma unroll
                for (int bj = 0; bj < 2; ++bj) st16_wt(E + (size_t)row * D_MODEL + col0 + bj * HALF, pack8(acc[ai][bj][m][0], acc[ai][bj][m][1])); }
    }
};
__device__ __forceinline__ void unpack8(u32x4 w, f32x4& a, f32x4& b) {
    a = (f32x4){__uint_as_float(w.x << 16), __uint_as_float(w.x & 0xffff0000u), __uint_as_float(w.y << 16), __uint_as_float(w.y & 0xffff0000u)};
    b = (f32x4){__uint_as_float(w.z << 16), __uint_as_float(w.z & 0xffff0000u), __uint_as_float(w.w << 16), __uint_as_float(w.w & 0xffff0000u)};
}
struct EpiMix {
    static constexpr bool PERM = true, AFTER_DRAIN = false; static constexpr int PBID = 34;
    const bf16_t* hsrc; bf16_t* hdst; LAS unsigned char* lds;
    __device__ __forceinline__ void operator()(const f32x4 (&acc)[2][2][4][2], const Unit& u, int wr, int wc, int fr, int fq) const {
        const int row0 = u.pm * BM + wr * 64 + fr, col0 = u.pn * BM + wc * 32 + 8 * fq;
        { LAS unsigned* dum = (LAS unsigned*)(lds + PFD_OFF + (wr * 4 + wc) * 1024);
          int row0p = row0; asm volatile("" : "+v"(row0p));
#pragma unroll
          for (int ai = 0; ai < 2; ++ai)
#pragma unroll
            for (int m = 0; m < 4; ++m)
#pragma unroll
                for (int bj = 0; bj < 2; ++bj) __builtin_amdgcn_global_load_lds((const unsigned*)(hsrc + (size_t)(row0p + ai * HALF + m * 16) * D_MODEL + col0 + bj * HALF), dum, 16, 0, 0); }
#pragma unroll
        for (int ai = 0; ai < 2; ++ai) {
            u32x4 hv[4][2];
#pragma unroll
            for (int m = 0; m < 4; ++m)
#pragma unroll
                for (int bj = 0; bj < 2; ++bj) hv[m][bj] = *(const u32x4*)(hsrc + (size_t)(row0 + ai * HALF + m * 16) * D_MODEL + col0 + bj * HALF);
#pragma unroll
            for (int m = 0; m < 4; ++m)
#pragma unroll
                for (int bj = 0; bj < 2; ++bj) { f32x4 a, b; unpack8(hv[m][bj], a, b);
                    st16_wt(hdst + (size_t)(row0 + ai * HALF + m * 16) * D_MODEL + col0 + bj * HALF, pack8(a + acc[ai][bj][m][0], b + acc[ai][bj][m][1])); }
            asm volatile("" ::: "memory");
        }
    }
};
struct EpiPle {
    static constexpr bool PERM = true, AFTER_DRAIN = false; static constexpr int PBID = 35;
    const bf16_t* h1; const bf16_t* E; bf16_t* hb; float* rowss; LAS unsigned char* lds;
    __device__ __forceinline__ void operator()(const f32x4 (&acc)[2][2][4][2], const Unit& u, int wr, int wc, int fr, int fq) const {
        const int row0 = u.pm * BM + wr * 64 + fr, col0 = u.pn * BM + wc * 32 + 8 * fq;
        { LAS unsigned* dum = (LAS unsigned*)(lds + PFD_OFF + (wr * 4 + wc) * 1024);
          int row0p = row0; asm volatile("" : "+v"(row0p));
#pragma unroll
          for (int ai = 0; ai < 2; ++ai)
#pragma unroll
            for (int m = 0; m < 4; ++m)
#pragma unroll
                for (int bj = 0; bj < 2; ++bj) { const size_t o = (size_t)(row0p + ai * HALF + m * 16) * D_MODEL + col0 + bj * HALF;
                    __builtin_amdgcn_global_load_lds((const unsigned*)(h1 + o), dum, 16, 0, 0); __builtin_amdgcn_global_load_lds((const unsigned*)(E + o), dum, 16, 0, 0); } }
#pragma unroll
        for (int ai = 0; ai < 2; ++ai) {
            u32x4 hv[4][2], ev[4][2];
#pragma unroll
            for (int m = 0; m < 4; ++m)
#pragma unroll
                for (int bj = 0; bj < 2; ++bj) { const size_t o = (size_t)(row0 + ai * HALF + m * 16) * D_MODEL + col0 + bj * HALF; hv[m][bj] = *(const u32x4*)(h1 + o); if (m < 2) ev[m][bj] = *(const u32x4*)(E + o); }
#pragma unroll
            for (int m = 0; m < 4; ++m) { const int row = row0 + ai * HALF + m * 16; float ss = 0.f;
                if (m == 2) {
                    asm volatile("" ::: "memory");
#pragma unroll
                    for (int m2 = 2; m2 < 4; ++m2)
#pragma unroll
                        for (int bj = 0; bj < 2; ++bj) ev[m2][bj] = *(const u32x4*)(E + (size_t)(row0 + ai * HALF + m2 * 16) * D_MODEL + col0 + bj * HALF);
                }
#pragma unroll
                for (int bj = 0; bj < 2; ++bj) { f32x4 ha, hb_, ea, eb; unpack8(hv[m][bj], ha, hb_); unpack8(ev[m][bj], ea, eb);
                    const f32x4 x0 = ha + sigmoid4(acc[ai][bj][m][0]) * ea, x1 = hb_ + sigmoid4(acc[ai][bj][m][1]) * eb;
                    st16_wt(hb + (size_t)row * D_MODEL + col0 + bj * HALF, pack8(x0, x1));
                    ss += ((x0[0] * x0[0] + x0[1] * x0[1]) + (x0[2] * x0[2] + x0[3] * x0[3])) + ((x1[0] * x1[0] + x1[1] * x1[1]) + (x1[2] * x1[2] + x1[3] * x1[3])); }
                ss += __shfl_xor(ss, 16); ss += __shfl_xor(ss, 32);
                if (fq == 0) rowss[(size_t)row * 16 + u.pn * 4 + wc] = ss; }
            asm volatile("" ::: "memory");
        }
    }
};

template <class Epi, class Sched, bool ALIGN_EPI = false, bool SP2 = false>
__device__ __forceinline__ void gemm_phase(LAS unsigned char* lds, const Gemm g, const Sched& S, const Epi& E, unsigned stagger_ticks = 0) {
    int tid_l = threadIdx.x; asm volatile("" : "+v"(tid_l));
    const int tid = tid_l, wid = __builtin_amdgcn_readfirstlane(tid >> 6), lane = tid & 63, wr = wid >> 2, wc = wid & 3, fr = lane & 15, fq = lane >> 4;
    const int K = g.K, nt = K / BK;
    unsigned voffA[2], voffB[2];
#pragma unroll
    for (int i = 0; i < 2; ++i) { int R, C; stage_rc(tid * 16 + i * 8192, R, C); const int Rb = Epi::PERM ? ((R & ~31) + perm32(R & 31)) : R;
        voffA[i] = (unsigned)(R * K + C) * 2u; voffB[i] = (unsigned)(Rb * K + C) * 2u; }
    const size_t kstep = (size_t)(BK * 2);
    const size_t hstep = (size_t)HALF * K * 2;
    const size_t tstep = 2 * hstep;
    const unsigned ldsw = (unsigned)wid * 1024u;
    const int aoff = lds_byte(wr * 64 + fr, fq * 8), boff = lds_byte(wc * 32 + fr, fq * 8);
#define PG8_SA(b, h) (((b) * 2 + (h)) * HTB)
#define PG8_SB(b, h) ((4 + (b) * 2 + (h)) * HTB)
#define PG8_STAGE(bufoff, gbase, voff) do { _Pragma("unroll") for (int _i = 0; _i < 2; ++_i) \
        __builtin_amdgcn_global_load_lds((const unsigned*)((const char*)(gbase) + (voff)[_i]), (LAS unsigned*)(lds + (bufoff) + ldsw + _i * 8192), 16, 0, 0); } while (0)
#define PG8_LDA(dst, b, h) do { _Pragma("unroll") for (int m = 0; m < 4; ++m) _Pragma("unroll") for (int k = 0; k < 2; ++k) dst[m][k] = *(const LAS bf16x8*)(lds + PG8_SA(b, h) + aoff + m * 2048 + k * 1024); } while (0)
#define PG8_LDB(dst, b, h) do { _Pragma("unroll") for (int n = 0; n < 2; ++n) _Pragma("unroll") for (int k = 0; k < 2; ++k) dst[n][k] = *(const LAS bf16x8*)(lds + PG8_SB(b, h) + boff + n * 2048 + k * 1024); } while (0)
#define PG8_MMA(ai, bj, At, Bt) do { __builtin_amdgcn_s_setprio(1); _Pragma("unroll") for (int m = 0; m < 4; ++m) _Pragma("unroll") for (int n = 0; n < 2; ++n) _Pragma("unroll") for (int k = 0; k < 2; ++k) \
        acc[ai][bj][m][n] = __builtin_amdgcn_mfma_f32_16x16x32_bf16(Bt[n][k], At[m][k], acc[ai][bj][m][n], 0, 0, 0); __builtin_amdgcn_s_setprio(0); } while (0)
#define PG8_WAIT_V(n) asm volatile("s_waitcnt vmcnt(" #n ")" ::: "memory")
#define PG8_WAIT_L(n) asm volatile("s_waitcnt lgkmcnt(" #n ")" ::: "memory")
#define PG8_BAR __builtin_amdgcn_s_barrier()
#define PG8_SCHED __builtin_amdgcn_sched_barrier(0)
    Unit cur, nxt; int ui = 0;
    if (!S.next(0, cur)) return;
    if (stagger_ticks) { const unsigned long long t0_ = __builtin_amdgcn_s_memrealtime(); while ((unsigned)(__builtin_amdgcn_s_memrealtime() - t0_) < stagger_ticks) __builtin_amdgcn_s_sleep(4); }
    PB_BEGIN(23)
    PB_BEGIN(22)
    f32x4 acc[2][2][4][2];
#pragma unroll
    for (int a = 0; a < 2; ++a)
#pragma unroll
        for (int b = 0; b < 2; ++b)
#pragma unroll
            for (int m = 0; m < 4; ++m)
#pragma unroll
                for (int n = 0; n < 2; ++n) acc[a][b][m][n] = (f32x4){0.f, 0.f, 0.f, 0.f};
    bf16x8 At[4][2], B0[2][2], B1[2][2];
    const char* cA = (const char*)g.A + (size_t)cur.pm * tstep; const char* cB = (const char*)g.Bt + (size_t)cur.pn * tstep;
    S.a_ready(cur);
    if constexpr (SP2) {
        PG8_STAGE(PG8_SB(0, 0), cB, voffB); PG8_STAGE(PG8_SB(0, 1), cB + hstep, voffB); PG8_STAGE(PG8_SA(0, 0), cA, voffA); PG8_STAGE(PG8_SA(0, 1), cA + hstep, voffA);
        if (wr == 1) PG8_BAR;
        PG8_WAIT_V(2); PG8_BAR;
        PG8_STAGE(PG8_SB(1, 0), cB + kstep, voffB); PG8_STAGE(PG8_SA(1, 0), cA + kstep, voffA); PG8_STAGE(PG8_SB(1, 1), cB + hstep + kstep, voffB);
        PG8_WAIT_V(6); PG8_BAR;
    } else {
        PG8_STAGE(PG8_SB(0, 0), cB, voffB); PG8_STAGE(PG8_SA(0, 0), cA, voffA); PG8_STAGE(PG8_SB(0, 1), cB + hstep, voffB); PG8_STAGE(PG8_SA(0, 1), cA + hstep, voffA);
        if (wr == 1) PG8_BAR;
        PG8_WAIT_V(4); PG8_BAR;
        PG8_STAGE(PG8_SB(1, 0), cB + kstep, voffB); PG8_STAGE(PG8_SA(1, 0), cA + kstep, voffA); PG8_STAGE(PG8_SB(1, 1), cB + hstep + kstep, voffB);
        PG8_WAIT_V(6); PG8_BAR;
    }
    PB_END(22, lds, (blockIdx.x == 0 && tid == 7 * 64))
#pragma unroll 1
    for (;;) {
        const bool has_next = S.next(ui + 1, nxt);
        const char* nA = has_next ? (const char*)g.A + (size_t)nxt.pm * tstep : cA; const char* nB = has_next ? (const char*)g.Bt + (size_t)nxt.pn * tstep : cB;
#pragma unroll 1
        for (int t = 0; t < nt; t += 2) {
            const bool last = (t == nt - 2);
            const char* a1 = cA + (size_t)(t + 1) * kstep;
            const char* a2 = last ? nA : cA + (size_t)(t + 2) * kstep; const char* b2 = last ? nB : cB + (size_t)(t + 2) * kstep;
            const char* a3 = a2 + kstep; const char* b3 = b2 + kstep;
            if (last && has_next) S.a_ready(nxt);
            if constexpr (SP2) {
            PG8_LDB(B0, 0, 0); PG8_LDB(B1, 0, 1); PG8_SCHED; PG8_LDA(At, 0, 0); PG8_STAGE(PG8_SA(1, 1), a1 + hstep, voffA);
            PG8_WAIT_V(8); PG8_WAIT_L(0); PG8_BAR; PG8_MMA(0, 0, At, B0); PG8_MMA(0, 1, At, B1); PG8_BAR; PG8_SCHED;
            PG8_LDA(At, 0, 1); PG8_STAGE(PG8_SB(0, 0), b2, voffB); PG8_STAGE(PG8_SB(0, 1), b2 + hstep, voffB); PG8_STAGE(PG8_SA(0, 0), a2, voffA);
            PG8_WAIT_V(8); PG8_WAIT_L(0); PG8_BAR; PG8_MMA(1, 0, At, B0); PG8_MMA(1, 1, At, B1); PG8_BAR; PG8_SCHED;
            PG8_LDB(B0, 1, 0); PG8_LDB(B1, 1, 1); PG8_SCHED; PG8_LDA(At, 1, 0); PG8_STAGE(PG8_SA(0, 1), a2 + hstep, voffA);
            PG8_WAIT_V(8); PG8_WAIT_L(0); PG8_BAR; PG8_MMA(0, 0, At, B0); PG8_MMA(0, 1, At, B1); PG8_BAR; PG8_SCHED;
            PG8_LDA(At, 1, 1); PG8_STAGE(PG8_SB(1, 0), b3, voffB); PG8_STAGE(PG8_SB(1, 1), b3 + hstep, voffB); PG8_STAGE(PG8_SA(1, 0), a3, voffA);
            PG8_WAIT_V(8); PG8_WAIT_L(0); PG8_BAR; PG8_MMA(1, 0, At, B0); PG8_MMA(1, 1, At, B1); PG8_BAR; PG8_SCHED;
            } else {
            PG8_LDB(B0, 0, 0); PG8_SCHED; PG8_LDA(At, 0, 0); PG8_STAGE(PG8_SA(1, 1), a1 + hstep, voffA);
            PG8_WAIT_L(8); PG8_BAR; PG8_WAIT_L(0); PG8_MMA(0, 0, At, B0); PG8_BAR; PG8_SCHED;
            PG8_LDB(B1, 0, 1); PG8_STAGE(PG8_SB(0, 0), b2, voffB);
            PG8_BAR; PG8_WAIT_L(0); PG8_MMA(0, 1, At, B1); PG8_BAR;
            PG8_LDA(At, 0, 1); PG8_STAGE(PG8_SA(0, 0), a2, voffA);
            PG8_BAR; PG8_WAIT_L(0); PG8_MMA(1, 0, At, B0); PG8_BAR; PG8_SCHED;
            PG8_STAGE(PG8_SB(0, 1), b2 + hstep, voffB);
            PG8_WAIT_V(6); PG8_BAR; PG8_MMA(1, 1, At, B1); PG8_BAR;
            PG8_LDB(B0, 1, 0); PG8_SCHED; PG8_LDA(At, 1, 0); PG8_STAGE(PG8_SA(0, 1), a2 + hstep, voffA);
            PG8_WAIT_L(8); PG8_BAR; PG8_WAIT_L(0); PG8_MMA(0, 0, At, B0); PG8_BAR; PG8_SCHED;
            PG8_LDB(B1, 1, 1); PG8_STAGE(PG8_SB(1, 0), b3, voffB);
            PG8_BAR; PG8_WAIT_L(0); PG8_MMA(0, 1, At, B1); PG8_BAR;
            PG8_LDA(At, 1, 1); PG8_STAGE(PG8_SA(1, 0), a3, voffA);
            PG8_BAR; PG8_WAIT_L(0); PG8_MMA(1, 0, At, B0); PG8_BAR; PG8_SCHED;
            PG8_STAGE(PG8_SB(1, 1), b3 + hstep, voffB);
            PG8_WAIT_V(6); PG8_BAR; PG8_MMA(1, 1, At, B1); PG8_BAR;
            }
        }
        if constexpr (ALIGN_EPI) { if (wr == 0) PG8_BAR; }
        { unsigned long long pbt_e = 0; if (PROBE_ID == 21 || PROBE_ID == Epi::PBID) { __builtin_amdgcn_sched_barrier(0); pbt_e = __builtin_amdgcn_s_memrealtime(); __builtin_amdgcn_sched_barrier(0); }
          if constexpr (!Epi::AFTER_DRAIN) { E(acc, cur, wr, wc, fr, fq); S.done(cur); }
          if (PROBE_ID == 21 || PROBE_ID == Epi::PBID) { __builtin_amdgcn_sched_barrier(0); const unsigned pbd_ = (unsigned)(__builtin_amdgcn_s_memrealtime() - pbt_e); __builtin_amdgcn_sched_barrier(0); if (blockIdx.x == 0 && tid == 7 * 64) *PB_WORD(lds) = *PB_WORD(lds) + pbd_; } }
        if (!has_next) break;
#pragma unroll
        for (int a = 0; a < 2; ++a)
#pragma unroll
            for (int b = 0; b < 2; ++b)
#pragma unroll
                for (int m = 0; m < 4; ++m)
#pragma unroll
                    for (int n = 0; n < 2; ++n) acc[a][b][m][n] = (f32x4){0.f, 0.f, 0.f, 0.f};
        cur = nxt; cA = nA; cB = nB; ++ui;
        if constexpr (ALIGN_EPI) { if (wr == 1) PG8_BAR; }
    }
    PG8_WAIT_V(0);
    if constexpr (!ALIGN_EPI) { if (wr == 0) PG8_BAR; }
    PG8_BAR;
    PB_END(23, lds, (blockIdx.x == 0 && tid == 7 * 64))
#undef PG8_SA
#undef PG8_SB
#undef PG8_STAGE
#undef PG8_LDA
#undef PG8_LDB
#undef PG8_MMA
#undef PG8_WAIT_V
#undef PG8_WAIT_L
#undef PG8_BAR
#undef PG8_SCHED
}
}

typedef GAS unsigned gu32;
#define RLX_AGENT __ATOMIC_RELAXED, __HIP_MEMORY_SCOPE_AGENT
#define LDS_WAIT() asm volatile("s_waitcnt lgkmcnt(0)" ::: "memory")
#define VM_WAIT() asm volatile("s_waitcnt vmcnt(0)" ::: "memory")
__device__ __forceinline__ unsigned f2bf(float f) { unsigned u = __builtin_bit_cast(unsigned, f); return (u + 0x7fffu + ((u >> 16) & 1u)) >> 16; }
__device__ __forceinline__ unsigned pk2(float lo, float hi) { return f2bf(lo) | (f2bf(hi) << 16); }
__device__ __forceinline__ float bflo(unsigned w) { return __uint_as_float(w << 16); }
__device__ __forceinline__ float bfhi(unsigned w) { return __uint_as_float(w & 0xffff0000u); }

constexpr int CW_BAR = 4096;
#define XB_TMO      128
#define XB_XCNT(j)  (256  + 64 * (j))
#define XB_XSUB(j)  (1280 + 64 * (j))
#define XB_XGEN(j)  (2304 + 64 * (j))
#define XB_TOP      3328
#define XB_TOPGEN   3392
#define XCD_BAR_WORDS 3456
#define XB_SPIN_CAP (1u << 20)
__device__ __forceinline__ unsigned xb_ld(unsigned* p)              { return __hip_atomic_load(p, __ATOMIC_RELAXED, __HIP_MEMORY_SCOPE_AGENT); }
__device__ __forceinline__ unsigned xb_add(unsigned* p, unsigned v) { return __hip_atomic_fetch_add(p, v, __ATOMIC_RELAXED, __HIP_MEMORY_SCOPE_AGENT); }
__device__ __forceinline__ unsigned xb_xcc_id() { return (unsigned)__builtin_amdgcn_s_getreg((3 << 11) | 20) & 0xFu; }
#define XB_SPIN(cond, bar) do { unsigned _sp = 0; while (cond) { __builtin_amdgcn_s_sleep(1); \
    if ((++_sp & 255u) == 0u) { if (xb_ld(&(bar)[XB_TMO])) break; if (_sp > XB_SPIN_CAP) { atomicAdd(&(bar)[XB_TMO], 1u); break; } } } } while (0)
struct XcdBarrier { unsigned* bar; unsigned x; volatile LAS unsigned* st; };
__device__ __forceinline__ XcdBarrier xcd_barrier_post(unsigned* bar, volatile LAS unsigned* st) {
    XcdBarrier b; b.bar = bar; b.x = xb_xcc_id(); b.st = st;
    if (threadIdx.x == 0) (void)xb_add(&bar[XB_XCNT(b.x)], 1u);
    return b;
}
__device__ __forceinline__ void xcd_barrier_complete(unsigned* bar, unsigned x, unsigned& nloc, unsigned& nx) {
    const unsigned G = gridDim.x * gridDim.y * gridDim.z;
    unsigned sum, cnt, mine, sp = 0u;
    for (;;) {
        sum = 0u; cnt = 0u; mine = 0u;
#pragma unroll
        for (unsigned j = 0; j < 16; ++j) { const unsigned c = xb_ld(&bar[XB_XCNT(j)]); sum += c; cnt += (c > 0u) ? 1u : 0u; mine = (j == x) ? c : mine; }
        if (sum == G) break;
        __builtin_amdgcn_s_sleep(1);
        if ((++sp & 255u) == 0u) { if (xb_ld(&bar[XB_TMO])) break; if (sp > XB_SPIN_CAP) { atomicAdd(&bar[XB_TMO], 1u); break; } }
    }
    nloc = mine > 0u ? mine : 1u; nx = cnt > 0u ? cnt : 1u;
}
__device__ __forceinline__ void xcd_barrier(const XcdBarrier& b) {
    asm volatile("s_waitcnt vmcnt(0)" ::: "memory");
    __syncthreads();
    if (threadIdx.x == 0) {
        unsigned* bar = b.bar; unsigned bx_ = b.x;
        asm volatile("" : "+s"(bar), "+s"(bx_));
        __builtin_amdgcn_s_waitcnt(0);
        unsigned nloc = b.st[0], nx = b.st[1];
        if (nloc == 0u) { xcd_barrier_complete(bar, bx_, nloc, nx); b.st[0] = nloc; b.st[1] = nx; }
        const unsigned old = xb_add(&bar[XB_XSUB(bx_)], 1u);
        const unsigned gen = old / nloc;
        if (old + 1u == (gen + 1u) * nloc) {
            __builtin_amdgcn_fence(__ATOMIC_RELEASE, "agent");
            asm volatile("s_waitcnt vmcnt(0)" ::: "memory");
            const unsigned og = xb_add(&bar[XB_TOP], 1u);
            const unsigned tg = og / nx;
            if (og + 1u == (tg + 1u) * nx) xb_add(&bar[XB_TOPGEN], 1u);
            else XB_SPIN(xb_ld(&bar[XB_TOPGEN]) == tg, bar);
            __builtin_amdgcn_fence(__ATOMIC_ACQUIRE, "agent");
            xb_add(&bar[XB_XGEN(bx_)], 1u);
            asm volatile("s_waitcnt vmcnt(0)" ::: "memory");
        } else {
            XB_SPIN(xb_ld(&bar[XB_XGEN(bx_)]) == gen, bar);
            __builtin_amdgcn_fence(__ATOMIC_ACQUIRE, "agent");
            asm volatile("s_waitcnt vmcnt(0)" ::: "memory");
        }
    }
    __syncthreads();
}

struct Args {
    const float* x; const float* p; const float* norm_g; const float* a_w_in; const float* a_ln_g; const float* a_ln_b; const float* a_w_s; const float* a_b_s; const float* a_w_out;
    const float* kv_norm_g; const float* w_kv; const float* b_w_in; const float* b_w_out; const float* ple_w; const float* ple_gate_w; const float* final_g;
    float* out; unsigned char* ws;
};

__device__ __forceinline__ float wave_sum(float v) {
#pragma unroll
    for (int o = 1; o < 64; o <<= 1) v += __shfl_xor(v, o);
    return v;
}

__device__ __forceinline__ int src_col(int mode, int n, int col_off) {
    if (mode == 0) return n + col_off;
    if (n < 4096) { const int t = n >> 8, j = n & 255; return j < 128 ? 128 * t + j : 4096 + 128 * t + (j - 128); }
    return 2048 + (n - 4096);
}
__device__ __forceinline__ void transpose_item(const float* W, int K, int Nsrc, int mode, int col_off, const float* scale, bf16_t* WT, LAS float* scr, int item, int lane, int nblk) {
    const int kb = item / nblk, nb = item % nblk, k0 = 64 * kb, n0 = 32 * nb, s0 = src_col(mode, n0, col_off);
    const int kl = lane >> 3, n4 = 4 * (lane & 7);
    f32x4 v[8];
#pragma unroll
    for (int i = 0; i < 8; ++i) v[i] = *(const f32x4*)(W + (size_t)(k0 + 8 * i + kl) * Nsrc + s0 + n4);
#pragma unroll
    for (int i = 0; i < 8; ++i) { const int kk = 8 * i + kl; const float sc = scale ? scale[k0 + kk] : 1.0f; LAS float* d = scr + kk * 33 + n4;
        d[0] = v[i][0] * sc; d[1] = v[i][1] * sc; d[2] = v[i][2] * sc; d[3] = v[i][3] * sc; }
    LDS_WAIT(); asm volatile("" ::: "memory");
    const int c = lane >> 3;
#pragma unroll
    for (int j = 0; j < 4; ++j) { const int n = (lane & 7) + 8 * j; const LAS float* s = scr + (8 * c) * 33 + n;
        u32x4 o; o.x = pk2(s[0 * 33], s[1 * 33]); o.y = pk2(s[2 * 33], s[3 * 33]); o.z = pk2(s[4 * 33], s[5 * 33]); o.w = pk2(s[6 * 33], s[7 * 33]);
        pg8::st16_wt(WT + (size_t)(n0 + n) * K + k0 + 8 * c, o); }
    LDS_WAIT(); asm volatile("" ::: "memory");
}
#define TJOB(W_, K_, Nsrc_, ndst_, mode_, coff_, scale_, WT_) do { const int nblk_ = (ndst_) / 32, items_ = ((K_) / 64) * nblk_; \
        for (int it_ = ((gw - jbase) % NGW + NGW) % NGW; it_ < items_; it_ += NGW) transpose_item((W_), (K_), (Nsrc_), (mode_), (coff_), (scale_), (WT_), scr, it_, lane, nblk_); \
        jbase = (jbase + items_) % NGW; } while (0)

__device__ __forceinline__ void convert_p(const float* src, bf16_t* dst, int gtid_in, int gthreads) {
    int gtid = gtid_in; asm volatile("" : "+v"(gtid));
    const int n8 = M * PLE_DIM / 8;
    for (int i = gtid; i < n8; i += gthreads) { const f32x4 a = *(const f32x4*)(src + (size_t)i * 8), b = *(const f32x4*)(src + (size_t)i * 8 + 4);
        u32x4 o; o.x = pk2(a[0], a[1]); o.y = pk2(a[2], a[3]); o.z = pk2(b[0], b[1]); o.w = pk2(b[2], b[3]); pg8::st16_wt(dst + (size_t)i * 8, o); }
}

__device__ __forceinline__ s16x4 mx_vtr(const LAS unsigned char* p) { return __builtin_bit_cast(s16x4, __builtin_amdgcn_ds_read_tr16_b64_v4i16((LAS s16x4*)p)); }
constexpr int MX_WM = 0, MX_LD = 136, MX_RSV = 544, MX_VT = 128 * MX_LD * 2, MX_ST = MX_VT + 128 * MX_RSV, MX_BS = MX_ST + 2 * 128 * 8, MX_END = MX_BS + 128 * 4;
static_assert(MX_END <= RING_BYTES, "mix LDS map");
__device__ __forceinline__ void mix_phase(LAS unsigned char* lds, int vcu, const float* wsm_l  , const float* bs_l  , const float* lng, const float* lnb,
                                          const bf16_t* GV, const bf16_t* UG, bf16_t* Yo, size_t ymask, const float* lnst, int tid_in) {
    int tid = tid_in; asm volatile("" : "+v"(tid));
    const int lane = tid & 63, wid = tid >> 6, g = vcu & 7, nb0 = vcu >> 3;
    LAS f32x2* ST = (LAS f32x2*)(lds + MX_ST); LAS float* BS = (LAS float*)(lds + MX_BS);
    { const float* wsm = wsm_l + (size_t)g * 128 * 128;
#pragma unroll
      for (int i = 0; i < 4; ++i) { const int idx = tid + 512 * i, t = idx >> 4, s8 = idx & 15;
        f32x4 a = *(const f32x4*)(wsm + t * 128 + s8 * 8), b = *(const f32x4*)(wsm + t * 128 + s8 * 8 + 4);
        if (t < 64 && s8 >= 8) { a = (f32x4){0.f, 0.f, 0.f, 0.f}; b = a; }
        u32x4 o; o.x = pk2(a[0], a[1]); o.y = pk2(a[2], a[3]); o.z = pk2(b[0], b[1]); o.w = pk2(b[2], b[3]);
        *(LAS u32x4*)(lds + MX_WM + t * (MX_LD * 2) + s8 * 16) = o; }
      if (tid < 128) BS[tid] = bs_l[g * 128 + tid]; }
    const int c8 = tid & 31, srow0 = tid >> 5;
    float lg[8], lb[8];
    { const f32x4 ga = *(const f32x4*)(lng + g * 256 + c8 * 8), gb = *(const f32x4*)(lng + g * 256 + c8 * 8 + 4), ba = *(const f32x4*)(lnb + g * 256 + c8 * 8), bb = *(const f32x4*)(lnb + g * 256 + c8 * 8 + 4);
#pragma unroll
      for (int e = 0; e < 4; ++e) { lg[e] = ga[e]; lg[4 + e] = gb[e]; lb[e] = ba[e]; lb[4 + e] = bb[e]; } }
    u32x4 gvr[8];
#define MX_LOADGV(nb_) do { _Pragma("unroll") for (int i_ = 0; i_ < 8; ++i_) gvr[i_] = *(const u32x4*)(GV + (size_t)((nb_) * 128 + srow0 + 16 * i_) * A_WIDTH + g * 256 + c8 * 8); } while (0)
#define MX_STATS(nb_, buf_) do { if (tid < 128) { const f32x4* p_ = (const f32x4*)(lnst + (size_t)((nb_) * 128 + tid) * 64); float s1_ = 0.f, s2_ = 0.f; \
        _Pragma("unroll") for (int i_ = 0; i_ < 16; ++i_) { const f32x4 v_ = p_[i_]; s1_ += v_[0] + v_[2]; s2_ += v_[1] + v_[3]; } \
        const float mean_ = s1_ * (1.0f / A_WIDTH), var_ = fmaxf(s2_ * (1.0f / A_WIDTH) - mean_ * mean_, 0.f); ST[(buf_) * 128 + tid] = (f32x2){mean_, 1.0f / sqrtf(var_ + EPS)}; } } while (0)
    MX_STATS(nb0, 0); MX_LOADGV(nb0);
    __syncthreads();
    const int fr = lane & 15, fq = lane >> 4;
#pragma unroll 1
    for (int k = 0; k < 4; ++k) {
        const int nb = nb0 + 32 * k;
        { const int wbk = c8 >> 2, m = c8 & 3;
#pragma unroll
          for (int i = 0; i < 8; ++i) { const int srow = srow0 + 16 * i; const f32x2 st = ST[(k & 1) * 128 + srow]; const u32x4 w = gvr[i];
            const float v[8] = {bflo(w.x), bfhi(w.x), bflo(w.y), bfhi(w.y), bflo(w.z), bfhi(w.z), bflo(w.w), bfhi(w.w)};
            float y[8];
#pragma unroll
            for (int e = 0; e < 8; ++e) y[e] = (v[e] - st.x) * st.y * lg[e] + lb[e];
            u32x2 lo, hi2; lo.x = pk2(y[0], y[1]); lo.y = pk2(y[2], y[3]); hi2.x = pk2(y[4], y[5]); hi2.y = pk2(y[6], y[7]);
            *(LAS u32x2*)(lds + MX_VT + srow * MX_RSV + wbk * 64 + m * 8) = lo; *(LAS u32x2*)(lds + MX_VT + srow * MX_RSV + wbk * 64 + 32 + m * 8) = hi2; } }
        if (k < 3) MX_LOADGV(nb + 32);
        __syncthreads();
        f32x4 acc[2][8];
#pragma unroll
        for (int ct = 0; ct < 2; ++ct)
#pragma unroll
            for (int tt = 0; tt < 8; ++tt) acc[ct][tt] = (f32x4){0.f, 0.f, 0.f, 0.f};
        const LAS unsigned char* vta = lds + MX_VT + (8 * fq + (fr >> 2)) * MX_RSV + wid * 64 + (fr & 3) * 8;
#pragma unroll
        for (int ks = 0; ks < 4; ++ks) {
            bf16x8 af[2];
#pragma unroll
            for (int ct = 0; ct < 2; ++ct) { const s16x4 lo = mx_vtr(vta + ks * 32 * MX_RSV + ct * 32), hh = mx_vtr(vta + ks * 32 * MX_RSV + ct * 32 + 4 * MX_RSV);
                af[ct] = (bf16x8){lo[0], lo[1], lo[2], lo[3], hh[0], hh[1], hh[2], hh[3]}; }
#pragma unroll
            for (int tt = 0; tt < 8; ++tt) {
                if (tt < 4 && ks >= 2) continue;
                const bf16x8 bfr = *(const LAS bf16x8*)(lds + MX_WM + (tt * 16 + fr) * (MX_LD * 2) + ks * 64 + fq * 16);
#pragma unroll
                for (int ct = 0; ct < 2; ++ct) acc[ct][tt] = __builtin_amdgcn_mfma_f32_16x16x32_bf16(af[ct], bfr, acc[ct][tt], 0, 0, 0);
            }
        }
#pragma unroll
        for (int tt = 0; tt < 8; ++tt) { const int t = tt * 16 + fr; const float b = BS[t];
            const size_t eo = (size_t)(nb * 128 + t) * A_WIDTH + g * 256 + wid * 32 + 8 * fq;
            const u32x4 w = *(const u32x4*)(UG + eo); const f32x4 a0 = acc[0][tt], a1 = acc[1][tt];
            u32x4 o; o.x = pk2(bflo(w.x) * (a0[0] + b), bfhi(w.x) * (a0[1] + b)); o.y = pk2(bflo(w.y) * (a0[2] + b), bfhi(w.y) * (a0[3] + b));
            o.z = pk2(bflo(w.z) * (a1[0] + b), bfhi(w.z) * (a1[1] + b)); o.w = pk2(bflo(w.w) * (a1[2] + b), bfhi(w.w) * (a1[3] + b));
            pg8::st16_wt(Yo + (eo & ymask), o); }
        if (k < 3) MX_STATS(nb + 32, (k + 1) & 1);
        __syncthreads();
    }
#undef MX_LOADGV
#undef MX_STATS
}

constexpr int AT_K = 0, AT_V = 32768, AT_KV_BYTES = 16384, AT_Q = 65536;
__device__ __forceinline__ int crow(int r, int hi) { return (r & 3) + 8 * (r >> 2) + 4 * hi; }
__device__ __forceinline__ s16x4 vtr(const LAS unsigned char* p) { return __builtin_bit_cast(s16x4, __builtin_amdgcn_ds_read_tr16_b64_v4i16((LAS s16x4*)p)); }
__device__ __forceinline__ float vmaxf(float a, float b) { float r; asm("v_max_f32_e32 %0, %1, %2" : "=v"(r) : "v"(a), "v"(b)); return r; }
template <int LITE = 0> __device__ __forceinline__ float sp_tail(float z) { if constexpr (LITE & 1) return 1.0f - __builtin_fabsf(z) * 0.01f; else return __builtin_amdgcn_logf(1.0f + __builtin_amdgcn_exp2f(-__builtin_fabsf(z))); }
template <int LITE = 0> __device__ __forceinline__ float ex2(float x) { if constexpr (LITE & 1) return x * 0.001f; else return __builtin_amdgcn_exp2f(x); }
struct AttnRegs { f32x16 o[4]; f32x16 y0, y1; float R, zf; };

template <bool QK, bool PV, bool DQK, bool DPV, int LITE = 0>
__device__ __forceinline__ void attn_step(AttnRegs& a, const LAS unsigned char* Kt, const LAS unsigned char* Vt, const LAS unsigned char* Qs,
                                          int lane, int qrelQK, int qrelPV, const bf16x8 (&ntri)[2], const bf16x8 none, LAS unsigned char* pb_lds, bool pb_on) {
    const int r32 = lane & 31, hi = lane >> 5;
    f32x16 zN0, zN1; u32x4 pw[4], xw[4];
    float tot = 0.f;
    if constexpr (PV) { tot = a.y0[0] - a.zf; const auto rr = __builtin_amdgcn_permlane32_swap(__float_as_uint(tot), __float_as_uint(tot), false, false); tot = __uint_as_float(rr[0]); }
    PB_BEGIN(2)
    bf16x8 kf[3][3];
    const int swz = r32 & 15;
#define AT_KLOAD(ds_) do { const int off_ = r32 * 256 + (((2 * (ds_) + hi) ^ swz) << 4); \
        if constexpr (LITE & 4) { kf[(ds_) % 3][0] = ntri[0]; kf[(ds_) % 3][1] = ntri[1]; kf[(ds_) % 3][2] = none; } else { \
        kf[(ds_) % 3][0] = *(const LAS bf16x8*)(Kt + off_); kf[(ds_) % 3][1] = *(const LAS bf16x8*)(Kt + off_ + 32 * 256); kf[(ds_) % 3][2] = *(const LAS bf16x8*)(Qs + off_); } } while (0)
    if constexpr (QK) {
#pragma unroll
        for (int r = 0; r < 16; ++r) { zN0[r] = 0.f; zN1[r] = 0.f; }
        AT_KLOAD(0); AT_KLOAD(1);
    }
#pragma unroll
    for (int ds = 0; ds < 8; ++ds) {
        if constexpr (QK) {
            if (ds + 2 < 8) AT_KLOAD(ds + 2);
            if constexpr (LITE & 8) { zN0[ds] += __builtin_bit_cast(f32x4, kf[ds % 3][0])[0] * __builtin_bit_cast(f32x4, kf[ds % 3][2])[1]; zN1[ds] += __builtin_bit_cast(f32x4, kf[ds % 3][1])[2] * __builtin_bit_cast(f32x4, kf[ds % 3][2])[3]; } else {
            zN0 = __builtin_amdgcn_mfma_f32_32x32x16_bf16(kf[ds % 3][0], kf[ds % 3][2], zN0, 0, 0, 0);
            zN1 = __builtin_amdgcn_mfma_f32_32x32x16_bf16(kf[ds % 3][1], kf[ds % 3][2], zN1, 0, 0, 0); }
        }
        if constexpr (PV) {
            const int r = 2 * ds;
            float a0, a1, b0, b1; if constexpr (LITE & 32) { a0 = a.y0[r]; a1 = a.y0[r + 1]; b0 = a.y1[r]; b1 = a.y1[r + 1]; } else { a0 = ex2<LITE>(a.y0[r] + a.R); a1 = ex2<LITE>(a.y0[r + 1] + a.R); b0 = ex2<LITE>(a.y1[r] + a.R); b1 = ex2<LITE>(a.y1[r + 1] + a.R); }
            if constexpr (DPV) { const int k0 = crow(r, hi), k1 = crow(r + 1, hi);
                a0 = (k0 < qrelPV) ? a0 : 0.f; a1 = (k1 < qrelPV) ? a1 : 0.f; b0 = (k0 + 32 < qrelPV) ? b0 : 0.f; b1 = (k1 + 32 < qrelPV) ? b1 : 0.f; }
            pw[r >> 3][(r >> 1) & 3] = pg8::cvt_pk_bf16(a0, a1); pw[2 + (r >> 3)][(r >> 1) & 3] = pg8::cvt_pk_bf16(b0, b1);
        }
        __builtin_amdgcn_sched_barrier(0);
    }
#undef AT_KLOAD
    if constexpr (PV) a.R += tot;
    PB_END(2, pb_lds, pb_on)
    PB_BEGIN(3)
    const LAS unsigned char* vb = Vt + ((lane >> 4) & 1) * 32 + (lane & 3) * 8 + (4 * hi + ((lane & 15) >> 2)) * 64;
    s16x4 vl[3], vh[3];
#define AT_VLOAD(i_) do { if constexpr (LITE & 4) { vl[(i_) % 3] = (s16x4){ntri[0][0], ntri[0][1], ntri[0][2], ntri[0][3]}; vh[(i_) % 3] = (s16x4){ntri[1][4], ntri[1][5], ntri[1][6], ntri[1][7]}; } else { \
        vl[(i_) % 3] = vtr(vb + ((i_) >> 2) * 4096 + ((i_) & 3) * 1024); vh[(i_) % 3] = vtr(vb + ((i_) >> 2) * 4096 + ((i_) & 3) * 1024 + 512); } } while (0)
    if constexpr (PV) { AT_VLOAD(0); AT_VLOAD(1); }
    float zfirst = 0.f;
#pragma unroll
    for (int i = 0; i < 16; ++i) {
        const int d = i >> 2, ks = i & 3;
        if constexpr (PV) {
            if (i + 2 < 16) AT_VLOAD(i + 2);
            const s16x4 lo = vl[i % 3], hh = vh[i % 3];
            const bf16x8 vf = (bf16x8){lo[0], lo[1], lo[2], lo[3], hh[0], hh[1], hh[2], hh[3]};
            if constexpr (LITE & 8) a.o[d][i & 15] += __builtin_bit_cast(f32x4, vf)[0] * __uint_as_float(pw[ks][i & 3]); else
            a.o[d] = __builtin_amdgcn_mfma_f32_32x32x16_bf16(__builtin_bit_cast(bf16x8, pw[ks]), vf, a.o[d], 0, 0, 0);
        }
        if constexpr (QK) {
            if (i == 0) zfirst = zN0[0];
            if (i < 8) { const int r = 2 * i;
                float z0 = zN0[r], z1 = zN0[r + 1]; asm volatile("" : "+v"(z0), "+v"(z1));
                float s0, s1; if constexpr (LITE & 32) { s0 = z0; s1 = z1; } else { s0 = vmaxf(z0, 0.f) + sp_tail<LITE>(z0); s1 = vmaxf(z1, 0.f) + sp_tail<LITE>(z1); }
                if constexpr (DQK) { s0 = (crow(r, hi) < qrelQK) ? s0 : 0.f; s1 = (crow(r + 1, hi) < qrelQK) ? s1 : 0.f; }
                if constexpr (!(LITE & 32)) { z0 -= s0; z1 -= s1; }
                unsigned xp = pg8::cvt_pk_bf16(s0, s1); asm volatile("" : "+v"(z0), "+v"(z1), "+v"(xp));
                zN0[r] = z0; zN0[r + 1] = z1; xw[r >> 3][(r >> 1) & 3] = xp;
            } else { const int r = 2 * (i - 8);
                float z0 = zN1[r], z1 = zN1[r + 1]; asm volatile("" : "+v"(z0), "+v"(z1));
                float s0, s1; if constexpr (LITE & 32) { s0 = z0; s1 = z1; } else { s0 = vmaxf(z0, 0.f) + sp_tail<LITE>(z0); s1 = vmaxf(z1, 0.f) + sp_tail<LITE>(z1); }
                if constexpr (DQK) { s0 = (crow(r, hi) + 32 < qrelQK) ? s0 : 0.f; s1 = (crow(r + 1, hi) + 32 < qrelQK) ? s1 : 0.f; }
                if constexpr (!(LITE & 32)) { z0 -= s0; z1 -= s1; }
                unsigned xp = pg8::cvt_pk_bf16(s0, s1); asm volatile("" : "+v"(z0), "+v"(z1), "+v"(xp));
                zN1[r] = z0; zN1[r + 1] = z1; xw[2 + (r >> 3)][(r >> 1) & 3] = xp;
            }
        }
        __builtin_amdgcn_sched_barrier(0);
    }
#undef AT_VLOAD
    PB_END(3, pb_lds, pb_on)
    PB_BEGIN(4)
    if constexpr (QK) {
        const bf16x8 x00 = __builtin_bit_cast(bf16x8, xw[0]), x01 = __builtin_bit_cast(bf16x8, xw[1]), x10 = __builtin_bit_cast(bf16x8, xw[2]), x11 = __builtin_bit_cast(bf16x8, xw[3]);
        zN0 = __builtin_amdgcn_mfma_f32_32x32x16_bf16(ntri[0], x00, zN0, 0, 0, 0);
        zN1 = __builtin_amdgcn_mfma_f32_32x32x16_bf16(ntri[0], x10, zN1, 0, 0, 0);
        zN0 = __builtin_amdgcn_mfma_f32_32x32x16_bf16(ntri[1], x01, zN0, 0, 0, 0);
        zN1 = __builtin_amdgcn_mfma_f32_32x32x16_bf16(ntri[1], x11, zN1, 0, 0, 0);
        zN0 = __builtin_amdgcn_mfma_f32_32x32x16_bf16(none, x10, zN0, 0, 0, 0);
        zN0 = __builtin_amdgcn_mfma_f32_32x32x16_bf16(none, x11, zN0, 0, 0, 0);
        a.y0 = zN0; a.y1 = zN1; a.zf = zfirst;
    }
    PB_END(4, pb_lds, pb_on)
}

template <int LITE = 0>
__device__ __forceinline__ void attn_unit(LAS unsigned char* lds, int b, int h, int qb, const bf16_t* Qb, const bf16_t* Kb, const bf16_t* Vb, const bf16_t* SG, bf16_t* OG, int tid_in) {
    int tid = tid_in; asm volatile("" : "+v"(tid));
    const int lane = tid & 63, wid = __builtin_amdgcn_readfirstlane(tid >> 6), r32 = lane & 31, hi = lane >> 5;
    const size_t rowbase = (size_t)b * SEQ;
    const int R0 = 256 * qb + 32 * wid;
    const int NT = 4 * qb + 4, jd = 4 * qb + (wid >> 1);
    const bool pb_on = (PROBE_ID != 0) && LITE == 0 && blockIdx.x == 0 && wid == 7 && lane == 0;
    PB_BEGIN(6)
    LAS unsigned char* Qs = lds + AT_Q + wid * 8192;
#pragma unroll
    for (int i = 0; i < 8; ++i) { const int p = lane + 64 * i, row = p >> 4, ch = p & 15;
        *(LAS u32x4*)(Qs + row * 256 + ((ch ^ (row & 15)) << 4)) = *(const u32x4*)(Qb + (rowbase + R0 + row) * D_MODEL + h * HEAD_DIM + ch * 8); }
    bf16x8 ntri[2], none;
#pragma unroll
    for (int s = 0; s < 2; ++s)
#pragma unroll
        for (int e = 0; e < 8; ++e) { const int j = 16 * s + 8 * (e >> 2) + 4 * hi + (e & 3); ntri[s][e] = (j > r32) ? (short)0xBF80 : (short)0; }
#pragma unroll
    for (int e = 0; e < 8; ++e) none[e] = (short)0xBF80;
    AttnRegs a;
#pragma unroll
    for (int d = 0; d < 4; ++d)
#pragma unroll
        for (int r = 0; r < 16; ++r) a.o[d][r] = 0.f;
#pragma unroll
    for (int r = 0; r < 16; ++r) { a.y0[r] = 0.f; a.y1[r] = 0.f; }
    a.R = 0.f; a.zf = 0.f;
    const bf16_t* Kh = Kb + rowbase * D_MODEL + h * HEAD_DIM; const bf16_t* Vh = Vb + rowbase * D_MODEL + h * HEAD_DIM;
    const bf16_t* ksrc[2]; const bf16_t* vsrc[2];
#pragma unroll
    for (int i = 0; i < 2; ++i) { const int pi = 2 * wid + i, key = 4 * pi + (lane >> 4), c = (lane & 15) ^ (key & 15);
        ksrc[i] = Kh + (size_t)key * D_MODEL + c * 8;
        const int vkey = 16 * (pi & 3) + (lane >> 2);
        vsrc[i] = Vh + (size_t)vkey * D_MODEL + (pi >> 2) * 32 + (lane & 3) * 8; }
    const unsigned ldsbase = (unsigned)(size_t)lds;
#define AT_GLDS(src_, dst_) do { unsigned keep_; asm volatile("s_mov_b32 %0, m0\n\ts_mov_b32 m0, %2\n\ts_nop 0\n\tglobal_load_lds_dwordx4 %1, off\n\ts_mov_b32 m0, %0" : "=&s"(keep_) : "v"(src_), "s"(dst_) : "memory"); } while (0)
#define AT_DMA_K(jt_, slot_) do { _Pragma("unroll") for (int i_ = 0; i_ < 2; ++i_) \
        AT_GLDS(ksrc[i_] + (size_t)(jt_) * 64 * D_MODEL, (unsigned)__builtin_amdgcn_readfirstlane(ldsbase + AT_K + (slot_) * AT_KV_BYTES + (2 * wid + i_) * 1024)); } while (0)
#define AT_DMA_V(jt_, slot_) do { _Pragma("unroll") for (int i_ = 0; i_ < 2; ++i_) \
        AT_GLDS(vsrc[i_] + (size_t)(jt_) * 64 * D_MODEL, (unsigned)__builtin_amdgcn_readfirstlane(ldsbase + AT_V + (slot_) * AT_KV_BYTES + (2 * wid + i_) * 1024)); } while (0)
#define AT_WAIT_BAR() do { PB_BEGIN(1) asm volatile("s_waitcnt vmcnt(0) lgkmcnt(0)" ::: "memory"); __builtin_amdgcn_s_barrier(); asm volatile("" ::: "memory"); PB_END(1, lds, pb_on) } while (0)
    AT_DMA_K(NT - 1, (NT - 1) & 1);
    PB_END(6, lds, pb_on)
    AT_WAIT_BAR();
#define AT_PRE(t_) do { PB_BEGIN(5) if constexpr (!(LITE & 16)) { if ((t_) >= 2) AT_DMA_K((t_) - 2, (t_) & 1); if ((t_) >= 1) AT_DMA_V((t_) - 1, ((t_) - 1) & 1); } PB_END(5, lds, pb_on) } while (0)
#define AT_KT(t_) (lds + AT_K + (((t_) - 1) & 1) * AT_KV_BYTES)
#define AT_VT(t_) (lds + AT_V + ((t_) & 1) * AT_KV_BYTES)
    int t = NT;
#pragma unroll 1
    for (; t > jd + 1; --t) { AT_PRE(t); AT_WAIT_BAR(); }
    { AT_PRE(t);
      if constexpr (!(LITE & 2)) attn_step<true, true, true, true, LITE>(a, AT_KT(t), AT_VT(t), Qs, lane, R0 - 64 * (t - 1) + r32, -(1 << 20), ntri, none, lds, pb_on);
      AT_WAIT_BAR(); --t; }
    { AT_PRE(t);
      if constexpr (!(LITE & 2)) attn_step<true, true, true, true, LITE>(a, AT_KT(t), AT_VT(t), Qs, lane, 1 << 20, R0 - 64 * t + r32, ntri, none, lds, pb_on);
      AT_WAIT_BAR(); --t; }
#pragma unroll 1
    for (; t >= 0; --t) { AT_PRE(t);
      if constexpr (!(LITE & 2)) attn_step<true, true, false, false, LITE>(a, AT_KT(t), AT_VT(t), Qs, lane, 0, 0, ntri, none, lds, pb_on);
      AT_WAIT_BAR(); }
#undef AT_PRE
#undef AT_KT
#undef AT_VT
#undef AT_DMA_K
#undef AT_GLDS
#undef AT_DMA_V
#undef AT_WAIT_BAR
    PB_BEGIN(7)
    { const bf16_t* SGw = SG + (rowbase + R0) * D_MODEL + h * HEAD_DIM; bf16_t* OGw = OG + (rowbase + R0) * D_MODEL + h * HEAD_DIM;
      int lane_e = lane; asm volatile("" : "+v"(lane_e) :: "memory");
      const int er = lane_e >> 4, ec = lane_e & 15;
#pragma unroll
      for (int hb = 0; hb < 2; ++hb) { u32x4 gt[4];
#pragma unroll
          for (int i = 0; i < 4; ++i) gt[i] = *(const u32x4*)(SGw + (size_t)(16 * hb + 4 * i + er) * D_MODEL + ec * 8);
#pragma unroll
          for (int i = 0; i < 4; ++i) *(LAS u32x4*)(Qs + (16 * hb + 4 * i + er) * 256 + ec * 16) = gt[i];
          asm volatile("" ::: "memory"); }
#pragma unroll
      for (int r = 0; r < 16; ++r) { LAS unsigned short* sp = (LAS unsigned short*)(Qs + crow(r, hi) * 256 + r32 * 2);
#pragma unroll
          for (int d = 0; d < 4; ++d) { const float gsv = __uint_as_float((unsigned)sp[d * 32] << 16); sp[d * 32] = (unsigned short)f2bf(a.o[d][r] * gsv); } }
#pragma unroll
      for (int i = 0; i < 8; ++i) { const u32x4 v = *(const LAS u32x4*)(Qs + (4 * i + er) * 256 + ec * 16);
          pg8::st16_wt(OGw + (size_t)(4 * i + er) * D_MODEL + ec * 8, v); } }
    if (PROBE_ID == 7) asm volatile("s_waitcnt vmcnt(0)" ::: "memory");
    PB_END(7, lds, pb_on)
}

__global__ void __launch_bounds__(NWAVES * 64, 2) yoco_fwd(Args args) {
    extern __shared__ __attribute__((aligned(16))) unsigned char lds_raw[];
    LAS unsigned char* lds = (LAS unsigned char*)lds_raw;
    volatile LAS unsigned* MISC = (volatile LAS unsigned*)(lds + MISC_OFF);
    const int tid = threadIdx.x, lane = tid & 63, wave = __builtin_amdgcn_readfirstlane(tid >> 6);
    const int G = gridDim.x; const int bx = blockIdx.x; const int vcu = (G % 8 == 0) ? (bx % 8) * (G / 8) + bx / 8 : bx;
    unsigned char* ws = args.ws;
    gu32* ctl = (gu32*)(ws + WS_CTL);
    for (int u = tid; u < (LDS_BYTES - LDSCTL_OFF) / 4; u += NWAVES * 64) ((LAS unsigned*)(lds + LDSCTL_OFF))[u] = 0u;
    __syncthreads();
    XcdBarrier bar = xcd_barrier_post((unsigned*)(ctl + CW_BAR), MISC + 8);
#define GRID_BAR() do { PB_BEGIN(20) for (int rep_ = 0; rep_ < DUP_BAR; ++rep_) xcd_barrier(bar); PB_END(20, lds, (blockIdx.x == 0 && tid == 7 * 64)) } while (0)

    float* rowss = (float*)(ws + WS_ROWSS); float* lnst = (float*)(ws + WS_LNST);
    bf16_t* WIN = (bf16_t*)(ws + WS_WIN); bf16_t* WOUT = (bf16_t*)(ws + WS_WOUT); bf16_t* WKVQ = (bf16_t*)(ws + WS_WKVQ); bf16_t* WQ3 = (bf16_t*)(ws + WS_WQ3);
    bf16_t* WBO = (bf16_t*)(ws + WS_WBO); bf16_t* WG = (bf16_t*)(ws + WS_WG); bf16_t* WP = (bf16_t*)(ws + WS_WP);
    bf16_t* PB = (bf16_t*)(ws + WS_PB); bf16_t* HB0 = (bf16_t*)(ws + WS_HB0);
    bf16_t* UG = (bf16_t*)(ws + WS_UG); bf16_t* GV = (bf16_t*)(ws + WS_GV);
    bf16_t* KB = (bf16_t*)(ws + WS_K); bf16_t* VB = (bf16_t*)(ws + WS_V); bf16_t* QB = (bf16_t*)(ws + WS_Q); bf16_t* SGB = (bf16_t*)(ws + WS_SG);
    bf16_t* OGB = (bf16_t*)args.out;

    for (int rep0 = 0; rep0 < DUP_P0; ++rep0) {
        int lane_p0 = tid & 63; asm volatile("" : "+v"(lane_p0)); const int lane = lane_p0;
        LAS float* scr = (LAS float*)(lds + wave * 16384);
        const int gw = vcu * NWAVES + wave, NGW = G * NWAVES; int jbase = 0;
        for (int i = 0; i < 2; ++i) TJOB(args.a_w_in + (size_t)i * D_MODEL * 6144, D_MODEL, 6144, 6144, 1, 0, args.norm_g + i * D_MODEL, WIN + (size_t)i * 6144 * D_MODEL);
        for (int i = 0; i < 2; ++i) TJOB(args.a_w_out + (size_t)i * A_WIDTH * D_MODEL, A_WIDTH, D_MODEL, D_MODEL, 0, 0, (const float*)nullptr, WOUT + (size_t)i * D_MODEL * A_WIDTH);
        TJOB(args.w_kv, D_MODEL, 2048, 2048, 0, 0, args.kv_norm_g, WKVQ);
        TJOB(args.b_w_in, D_MODEL, 2048, 2048, 0, 0, args.norm_g + 2 * D_MODEL, WKVQ + (size_t)2048 * D_MODEL);
        TJOB(args.b_w_in + (size_t)D_MODEL * 2048, D_MODEL, 2048, 2048, 0, 0, args.norm_g + 3 * D_MODEL, WQ3);
        for (int i = 0; i < 2; ++i) TJOB(args.b_w_out + (size_t)i * D_MODEL * D_MODEL, D_MODEL, D_MODEL, D_MODEL, 0, 0, (const float*)nullptr, WBO + (size_t)i * D_MODEL * D_MODEL);
        for (int i = 0; i < 4; ++i) TJOB(args.ple_gate_w + (size_t)i * D_MODEL * D_MODEL, D_MODEL, D_MODEL, D_MODEL, 0, 0, (const float*)nullptr, WG + (size_t)i * D_MODEL * D_MODEL);
        for (int i = 0; i < 4; ++i) TJOB(args.ple_w + (size_t)i * PLE_DIM * D_MODEL, PLE_DIM, D_MODEL, D_MODEL, 0, 0, (const float*)nullptr, WP + (size_t)i * D_MODEL * PLE_DIM);
        for (int m = gw; m < M; m += 2 * NGW) {
            const int m2 = m + NGW;
            const f32x4* xr = (const f32x4*)(args.x + (size_t)m * D_MODEL) + 2 * lane; const f32x4* xr2 = (const f32x4*)(args.x + (size_t)m2 * D_MODEL) + 2 * lane;
            f32x4 va[4], vb[4];
#pragma unroll
            for (int j = 0; j < 2; ++j) { va[2 * j] = xr[128 * j]; va[2 * j + 1] = xr[128 * j + 1]; vb[2 * j] = xr2[128 * j]; vb[2 * j + 1] = xr2[128 * j + 1]; }
            float s = 0.f, s2 = 0.f;
#pragma unroll
            for (int j = 0; j < 4; ++j) { s += (va[j][0] * va[j][0] + va[j][1] * va[j][1]) + (va[j][2] * va[j][2] + va[j][3] * va[j][3]); s2 += (vb[j][0] * vb[j][0] + vb[j][1] * vb[j][1]) + (vb[j][2] * vb[j][2] + vb[j][3] * vb[j][3]); }
#pragma unroll
            for (int j = 0; j < 2; ++j) {
                u32x4 o; o.x = pk2(va[2 * j][0], va[2 * j][1]); o.y = pk2(va[2 * j][2], va[2 * j][3]); o.z = pk2(va[2 * j + 1][0], va[2 * j + 1][1]); o.w = pk2(va[2 * j + 1][2], va[2 * j + 1][3]);
                pg8::st16_wt(HB0 + (size_t)m * D_MODEL + 512 * j + 8 * lane, o);
                o.x = pk2(vb[2 * j][0], vb[2 * j][1]); o.y = pk2(vb[2 * j][2], vb[2 * j][3]); o.z = pk2(vb[2 * j + 1][0], vb[2 * j + 1][1]); o.w = pk2(vb[2 * j + 1][2], vb[2 * j + 1][3]);
                pg8::st16_wt(HB0 + (size_t)m2 * D_MODEL + 512 * j + 8 * lane, o); }
            s = wave_sum(s); s2 = wave_sum(s2);
            if (lane < 16) { rowss[(size_t)m * 16 + lane] = (lane == 0) ? s : 0.f; rowss[(size_t)m2 * 16 + lane] = (lane == 0) ? s2 : 0.f; }
        }
        convert_p(args.p, PB, vcu * 512 + tid, G * 512);
    }
    GRID_BAR();

    for (int L = 0; L < DEPTH; ++L) {
        bf16_t* Ebuf = (L < N_A) ? (bf16_t*)(ws + WS_EA) : (bf16_t*)(ws + WS_EB);
        bf16_t* HB1 = (L < N_A) ? (bf16_t*)(ws + WS_HB1A) : (bf16_t*)(ws + WS_HB1B);
        if (L < N_A) {
            { pg8::Gemm g{HB0, WIN + (size_t)L * 6144 * D_MODEL, M, 6144, D_MODEL}; pg8::StaticOrder S; S.init(M, 6144, G, bx);
              pg8::fill_rstd(lds, rowss, S, tid);
              pg8::EpiA1 E{UG, GV, lnst, (const LAS float*)(lds + RSTD_OFF)};
              for (int rep = 0; rep < DUP_A1; ++rep) pg8::gemm_phase<pg8::EpiA1, pg8::StaticOrder, true, true>(lds, g, S, E, (unsigned)(vcu & 7) * STAGGER_TICKS); }
            GRID_BAR();
            if (L > 0) convert_p(args.p + (size_t)L * M * PLE_DIM, PB, vcu * 512 + tid, G * 512);
            if (G == 256) for (int rep = 0; rep < DUP_MIX; ++rep)
                mix_phase(lds, vcu, args.a_w_s + (size_t)L * A_GROUPS * 128 * 128, args.a_b_s + (size_t)L * A_GROUPS * 128, args.a_ln_g + (size_t)L * A_WIDTH, args.a_ln_b + (size_t)L * A_WIDTH,
                          GV, UG, rep + 1 < DUP_MIX ? OGB : UG, rep + 1 < DUP_MIX ? (size_t)(16u * MiB - 1) : ~(size_t)0, lnst, tid);
            GRID_BAR();
            { pg8::Gemm g{UG, WOUT + (size_t)L * D_MODEL * A_WIDTH, M, D_MODEL, A_WIDTH}; pg8::StaticOrder S; S.init(M, D_MODEL, G, bx);
              pg8::EpiMix E{HB0, HB1, lds};
              for (int rep = 0; rep < DUP_MIXG; ++rep) pg8::gemm_phase<pg8::EpiMix, pg8::StaticOrder, true, true>(lds, g, S, E); }
        } else {
            const int j = L - N_A;
            { pg8::Gemm g{HB0, j == 0 ? WKVQ : WQ3, M, j == 0 ? 4096 : 2048, D_MODEL}; pg8::StaticOrder S; S.init(M, g.N, G, bx);
              pg8::fill_rstd(lds, rowss, S, tid);
              pg8::EpiKVQ E{KB, VB, QB, SGB, (const LAS float*)(lds + RSTD_OFF), j == 0 ? 0 : 2};
              for (int rep = 0; rep < DUP_KVQ; ++rep) pg8::gemm_phase<pg8::EpiKVQ, pg8::StaticOrder, true, true>(lds, g, S, E, (unsigned)(vcu & 7) * STAGGER_TICKS); }
            GRID_BAR();
            convert_p(args.p + (size_t)L * M * PLE_DIM, PB, vcu * 512 + tid, G * 512);
            { const int xg = vcu >> 5, l = vcu & 31, bh1 = 8 * xg + (l >> 3), bh2 = bh1 + 4, q1 = l & 7, q2 = 7 - q1;
              if (G == 256) {
                  for (int rep = 1; rep < DUP_ATTN; ++rep) {
                  attn_unit<DUP_LITE>(lds, bh1 >> 3, bh1 & 7, q1, QB, KB, VB, SGB, OGB + (size_t)M * D_MODEL, tid);
                  attn_unit<DUP_LITE>(lds, bh2 >> 3, bh2 & 7, q2, QB, KB, VB, SGB, OGB + (size_t)M * D_MODEL, tid); }
                  attn_unit(lds, bh1 >> 3, bh1 & 7, q1, QB, KB, VB, SGB, OGB, tid);
                  attn_unit(lds, bh2 >> 3, bh2 & 7, q2, QB, KB, VB, SGB, OGB, tid);
              } }
            GRID_BAR();
            { pg8::Gemm g{OGB, WBO + (size_t)j * D_MODEL * D_MODEL, M, D_MODEL, D_MODEL}; pg8::StaticOrder S; S.init(M, D_MODEL, G, bx);
              pg8::EpiMix E{HB0, HB1, lds};
              for (int rep = 0; rep < DUP_MIXG; ++rep) pg8::gemm_phase<pg8::EpiMix, pg8::StaticOrder, true, true>(lds, g, S, E); }
        }
        { pg8::Gemm g{PB, WP + (size_t)L * D_MODEL * PLE_DIM, M, D_MODEL, PLE_DIM}; pg8::StaticOrder S; S.init(M, D_MODEL, G, bx);
          pg8::EpiE E{Ebuf};
          for (int rep = 0; rep < DUP_E; ++rep) pg8::gemm_phase<pg8::EpiE, pg8::StaticOrder, true, true>(lds, g, S, E); }
        GRID_BAR();
        { pg8::Gemm g{HB1, WG + (size_t)L * D_MODEL * D_MODEL, M, D_MODEL, D_MODEL}; pg8::StaticOrder S; S.init(M, D_MODEL, G, bx);
          pg8::EpiPle E{HB1, Ebuf, HB0, rowss, lds};
          for (int rep = 0; rep < DUP_PLE; ++rep) pg8::gemm_phase<pg8::EpiPle, pg8::StaticOrder, true, true>(lds, g, S, E); }
        GRID_BAR();
    }
    {
        int lane_fn = tid & 63; asm volatile("" : "+v"(lane_fn)); const int lane = lane_fn;
        const int gw = vcu * NWAVES + wave, NGW = G * NWAVES;
        f32x4 gv[4];
#pragma unroll
        for (int j = 0; j < 4; ++j) gv[j] = *((const f32x4*)args.final_g + lane + 64 * j);
        for (int m = gw; m < M; m += NGW) {
            const u32x2* hr = (const u32x2*)(HB0 + (size_t)m * D_MODEL) + lane; f32x4* orow = (f32x4*)(args.out + (size_t)m * D_MODEL) + lane; f32x4 v[4]; float s = 0.f;
#pragma unroll
            for (int j = 0; j < 4; ++j) { const u32x2 w = hr[64 * j]; v[j] = (f32x4){bflo(w.x), bfhi(w.x), bflo(w.y), bfhi(w.y)}; s += (v[j][0] * v[j][0] + v[j][1] * v[j][1]) + (v[j][2] * v[j][2] + v[j][3] * v[j][3]); }
            const float rstd = 1.0f / sqrtf(wave_sum(s) * (1.0f / D_MODEL) + EPS);
#pragma unroll
            for (int j = 0; j < 4; ++j) orow[64 * j] = v[j] * rstd * gv[j];
        }
    }
    if (PROBE_ID != 0 && blockIdx.x == 0) {
        __syncthreads();
        if (tid == 7 * 64) { const unsigned w = *PB_WORD(lds); const unsigned long long t0 = __builtin_amdgcn_s_memrealtime(); while ((unsigned)(__builtin_amdgcn_s_memrealtime() - t0) < w) __builtin_amdgcn_s_sleep(8); }
    }
}

extern "C" void kernel_launch(void* const* d_in, const int* in_sizes, int n_in, void* d_out, int out_size, void* d_ws, size_t ws_size, hipStream_t stream) {
    static int grid = 0;
    if (grid == 0) {
        if (n_in != 16 || in_sizes[0] != M * D_MODEL || out_size != M * D_MODEL || ws_size < WS_END) { fprintf(stderr, "kernel_launch: unexpected shapes (n_in %d, ws %zu); nothing launched\n", n_in, ws_size); grid = -1; return; }
        int dev = 0, cus = 0, per_cu = 0;
        if (hipGetDevice(&dev) != hipSuccess || hipDeviceGetAttribute(&cus, hipDeviceAttributeMultiprocessorCount, dev) != hipSuccess) { grid = -1; return; }
        if (hipFuncSetAttribute((const void*)yoco_fwd, hipFuncAttributeMaxDynamicSharedMemorySize, LDS_BYTES) != hipSuccess) { fprintf(stderr, "kernel_launch: hipFuncSetAttribute failed\n"); grid = -1; return; }
        if (hipOccupancyMaxActiveBlocksPerMultiprocessor(&per_cu, (const void*)yoco_fwd, NWAVES * 64, LDS_BYTES) != hipSuccess || per_cu < 1) { fprintf(stderr, "kernel_launch: occupancy query says %d blocks per CU\n", per_cu); per_cu = 1; }
        (void)hipGetLastError();
        grid = cus * 1;
    }
    if (grid < 0) return;
    (void)hipMemsetAsync((char*)d_ws + WS_CTL, 0, CTL_ZERO_BYTES, stream);
    Args a{};
    a.x = (const float*)d_in[0]; a.p = (const float*)d_in[1]; a.norm_g = (const float*)d_in[2]; a.a_w_in = (const float*)d_in[3]; a.a_ln_g = (const float*)d_in[4]; a.a_ln_b = (const float*)d_in[5];
    a.a_w_s = (const float*)d_in[6]; a.a_b_s = (const float*)d_in[7]; a.a_w_out = (const float*)d_in[8]; a.kv_norm_g = (const float*)d_in[9]; a.w_kv = (const float*)d_in[10]; a.b_w_in = (const float*)d_in[11];
    a.b_w_out = (const float*)d_in[12]; a.ple_w = (const float*)d_in[13]; a.ple_gate_w = (const float*)d_in[14]; a.final_g = (const float*)d_in[15];
    a.out = (float*)d_out; a.ws = (unsigned char*)d_ws;
    void* kargs[] = {&a};
    hipError_t e = hipLaunchCooperativeKernel((const void*)yoco_fwd, dim3(grid), dim3(NWAVES * 64), kargs, LDS_BYTES, stream);
    if (e != hipSuccess) fprintf(stderr, "kernel_launch: cooperative launch failed: %s (grid %d)\n", hipGetErrorString(e), grid);
}
```

```cpp
#include <hip/hip_runtime.h>
#include <hip/hip_cooperative_groups.h>
#include <cstdio>
#include <cstdint>

#define LAS __attribute__((address_space(3)))
#define GAS __attribute__((address_space(1)))
typedef unsigned short bf16_t;
typedef short bf16x8 __attribute__((ext_vector_type(8)));
typedef short s16x4 __attribute__((ext_vector_type(4)));
typedef float f32x4 __attribute__((ext_vector_type(4)));
typedef float f32x2 __attribute__((ext_vector_type(2)));
typedef float f32x16 __attribute__((ext_vector_type(16)));
typedef unsigned u32x4 __attribute__((ext_vector_type(4)));
typedef unsigned u32x2 __attribute__((ext_vector_type(2)));

#define DUP_ATTN 1
#define DUP_LITE 0
#define DUP_A1 1
#define DUP_KVQ 1
#define DUP_E 1
#define DUP_P0 1
#define DUP_BAR 1
#define DUP_MIX 1
#define DUP_MIXG 1
#define DUP_PLE 1
#define PROBE_ID 0
#define STAGGER_TICKS 0u
#define PB_WORD(lds_) ((volatile LAS unsigned*)((lds_) + MISC_OFF + 64))
#define PB_BEGIN(id_) unsigned long long pbt_##id_ = 0; if (PROBE_ID == (id_)) { __builtin_amdgcn_sched_barrier(0); pbt_##id_ = __builtin_amdgcn_s_memrealtime(); __builtin_amdgcn_sched_barrier(0); }
#define PB_END(id_, lds_, on_) if (PROBE_ID == (id_)) { __builtin_amdgcn_sched_barrier(0); const unsigned pbd_ = (unsigned)(__builtin_amdgcn_s_memrealtime() - pbt_##id_); __builtin_amdgcn_sched_barrier(0); if (on_) *PB_WORD(lds_) = *PB_WORD(lds_) + pbd_; }
constexpr int D_MODEL = 1024, BATCH = 8, SEQ = 2048, DEPTH = 4, N_A = 2, A_WIDTH = 2048, A_GROUPS = 8, B_HEADS = 8, HEAD_DIM = 128, PLE_DIM = 256;
constexpr int M = BATCH * SEQ;
constexpr float EPS = 1e-6f;
constexpr float LOG2E = 1.4426950408889634f;
constexpr float QSCALE = 0.08838834764831845f * LOG2E;

constexpr size_t MiB = 1u << 20;
constexpr size_t WS_CTL = 0, CTL_ZERO_BYTES = 64 * 1024;
constexpr size_t WS_ROWSS = 1 * MiB;
constexpr size_t WS_LNST = 2 * MiB;
constexpr size_t WS_WIN = 6 * MiB;
constexpr size_t WS_WOUT = 30 * MiB;
constexpr size_t WS_WKVQ = 38 * MiB;
constexpr size_t WS_WQ3 = 46 * MiB;
constexpr size_t WS_WBO = 50 * MiB;
constexpr size_t WS_WG = 54 * MiB;
constexpr size_t WS_WP = 62 * MiB;
constexpr size_t WS_PB = 64 * MiB;
constexpr size_t WS_HB0 = 72 * MiB;
constexpr size_t WS_REG = 104 * MiB;
constexpr size_t WS_UG = WS_REG, WS_GV = WS_REG + 64 * MiB;
constexpr size_t WS_K = WS_REG, WS_V = WS_REG + 32 * MiB, WS_Q = WS_REG + 64 * MiB, WS_SG = WS_REG + 96 * MiB;
constexpr size_t WS_EA = WS_GV, WS_HB1A = WS_GV + 32 * MiB;
constexpr size_t WS_EB = WS_SG, WS_HB1B = WS_WIN;
constexpr size_t WS_END = 232 * MiB;

constexpr int RING_BYTES = 131072;
constexpr int LDSCTL_OFF = RING_BYTES, MISC_OFF = LDSCTL_OFF + 320;
constexpr int LDS_BYTES = 155648;
constexpr int PFD_OFF = LDSCTL_OFF + 1024 + 8192;
constexpr int RSTD_OFF = LDSCTL_OFF + 1024;
constexpr int NWAVES = 8;

namespace pg8 {
constexpr int BM = 256, BK = 64, HALF = 128, HTB = HALF * BK * 2, STAGE_BYTES = 8 * HTB, NXCD = 8, WGM = 8;
__host__ __device__ __forceinline__ int lds_byte(int r, int c) { const int st = (r >> 4) * 2 + (c >> 5), rr = r & 15, cc = c & 31, ob = rr * 64 + cc * 2; return st * 1024 + (ob ^ (((ob >> 9) & 1) << 5)); }
__host__ __device__ __forceinline__ void stage_rc(int b, int& R, int& C) { const int st = b / 1024, sb = b % 1024, swz = sb ^ (((sb >> 9) & 1) << 5); R = (st >> 1) * 16 + swz / 64; C = (st & 1) * 32 + (swz % 64) / 2; }
__host__ __device__ __forceinline__ int perm32(int rho) { const int n = rho >> 4, i = rho & 15; return 8 * (i >> 2) + 4 * n + (i & 3); }

struct Unit { int pm, pn, ord; };
struct Gemm { const bf16_t* A; const bf16_t* Bt; int M, N, K; };

struct StaticOrder {
    int nM, nN, nwg, G, c;
    __host__ __device__ void init(int M_, int N_, int G_, int c_) { nM = M_ / BM; nN = N_ / BM; nwg = nM * nN; G = G_; c = c_; }
    __host__ __device__ bool next(int i, Unit& u) const {
        const long L = (long)i * G + c; if (L >= nwg) return false;
        int wgid = (int)L; { const int q = nwg / NXCD, r = nwg % NXCD, xcd = wgid % NXCD, off = wgid / NXCD; wgid = (xcd < r ? xcd * (q + 1) : r * (q + 1) + (xcd - r) * q) + off; }
        const int nig = WGM * nN, gid = wgid / nig, fm = gid * WGM, gsz = (nM - fm) < WGM ? (nM - fm) : WGM;
        u.pm = fm + ((wgid % nig) % gsz); u.pn = (wgid % nig) / gsz; u.ord = i; return true;
    }
    __device__ __forceinline__ void a_ready(const Unit&) const {}
    __device__ __forceinline__ void done(const Unit&) const {}
};

__device__ __forceinline__ unsigned cvt_pk_bf16(float lo, float hi) { unsigned r; asm volatile("v_cvt_pk_bf16_f32 %0, %1, %2" : "=v"(r) : "v"(lo), "v"(hi)); return r; }

__device__ __forceinline__ f32x2 gelu_pk(f32x2 v) {
    const f32x2 av = __builtin_elementwise_abs(v), d = av * 0.2316418882f + 1.0f;
    f32x2 t; t.x = __builtin_amdgcn_rcpf(d.x); t.y = __builtin_amdgcn_rcpf(d.y);
    f32x2 q = t * 0.5307027145f + (-0.7265760135f); q = q * t + 0.7107068705f; q = q * t + (-0.142248368f); q = q * t + 0.127414796f; q = q * t;
    const f32x2 s = (v * v) * (-0.72134752044f);
    f32x2 e; e.x = __builtin_amdgcn_exp2f(s.x); e.y = __builtin_amdgcn_exp2f(s.y);
    const f32x2 m = v * (q * e), r = v - m;
    f32x2 o; o.x = v.x < 0.f ? m.x : r.x; o.y = v.y < 0.f ? m.y : r.y; return o;
}
__device__ __forceinline__ f32x4 gelu4(f32x4 v) { const f32x2 a = gelu_pk((f32x2){v[0], v[1]}), b = gelu_pk((f32x2){v[2], v[3]}); return (f32x4){a.x, a.y, b.x, b.y}; }
__device__ __forceinline__ float sigmoid1(float x) { return __builtin_amdgcn_rcpf(1.0f + __builtin_amdgcn_exp2f(-LOG2E * x)); }
__device__ __forceinline__ f32x4 sigmoid4(f32x4 v) { return (f32x4){sigmoid1(v[0]), sigmoid1(v[1]), sigmoid1(v[2]), sigmoid1(v[3])}; }
__device__ __forceinline__ f32x4 silu4(f32x4 v) { return v * sigmoid4(v); }

__device__ __forceinline__ void load_rstd(const LAS float* tab, int ord, int wr, int fr, float (&rs)[2][4]) {
#pragma unroll
    for (int ai = 0; ai < 2; ++ai)
#pragma unroll
        for (int m = 0; m < 4; ++m) rs[ai][m] = tab[ord * 256 + ai * HALF + wr * 64 + m * 16 + fr];
}
template <class Sched>
__device__ __forceinline__ void fill_rstd(LAS unsigned char* lds, const float* rowss, const Sched& S, int tid_in) {
    LAS float* tab = (LAS float*)(lds + RSTD_OFF);
    int tid = tid_in; asm volatile("" : "+v"(tid));
    Unit u;
#pragma unroll 1
    for (int i = 0; i < 8 && S.next(i, u); ++i)
        if (tid < 256) { const f32x4* p = (const f32x4*)(rowss + (size_t)(u.pm * BM + tid) * 16); const f32x4 a = p[0], b = p[1], c = p[2], d = p[3];
            const float s = ((a[0] + a[1]) + (a[2] + a[3])) + ((b[0] + b[1]) + (b[2] + b[3])) + ((c[0] + c[1]) + (c[2] + c[3])) + ((d[0] + d[1]) + (d[2] + d[3]));
            tab[i * 256 + tid] = 1.0f / sqrtf(s * (1.0f / D_MODEL) + EPS); }
    asm volatile("s_waitcnt lgkmcnt(0)" ::: "memory");
}
__device__ __forceinline__ u32x4 pack8(f32x4 v0, f32x4 v1) { u32x4 w; w.x = cvt_pk_bf16(v0[0], v0[1]); w.y = cvt_pk_bf16(v0[2], v0[3]); w.z = cvt_pk_bf16(v1[0], v1[1]); w.w = cvt_pk_bf16(v1[2], v1[3]); return w; }
__device__ __forceinline__ void st16_wt(void* p, u32x4 v) { asm volatile("global_store_dwordx4 %0, %1, off sc1\n\ts_nop 1" :: "v"(p), "v"(v) : "memory"); }
__device__ __forceinline__ u32x2 pack4(f32x4 v0) { u32x2 w; w.x = cvt_pk_bf16(v0[0], v0[1]); w.y = cvt_pk_bf16(v0[2], v0[3]); return w; }

struct EpiA1 {
    static constexpr bool PERM = true, AFTER_DRAIN = false; static constexpr int PBID = 31;
    bf16_t* UG; bf16_t* GV; float* lnst; const LAS float* rtab;
    __device__ __forceinline__ void operator()(const f32x4 (&acc)[2][2][4][2], const Unit& u, int wr, int wc, int fr, int fq) const {
        const int row0 = u.pm * BM + wr * 64 + fr;
        float rs[2][4]; load_rstd(rtab, u.ord, wr, fr, rs);
        if (u.pn < 16) {
            const int ch0 = u.pn * 128 + wc * 32 + 8 * fq;
#pragma unroll
            for (int ai = 0; ai < 2; ++ai)
#pragma unroll
                for (int m = 0; m < 4; ++m) {
                    const float r = rs[ai][m]; const int row = row0 + ai * HALF + m * 16;
                    const f32x4 u0 = gelu4(acc[ai][0][m][0] * r), u1 = gelu4(acc[ai][0][m][1] * r);
                    const f32x4 g0 = silu4(acc[ai][1][m][0] * r), g1 = silu4(acc[ai][1][m][1] * r);
                    st16_wt(UG + (size_t)row * A_WIDTH + ch0, pack8(u0 * g0, u1 * g1));
                }
        } else {
            const int g = u.pn - 16, ch0 = g * 256 + wc * 32 + 8 * fq;
#pragma unroll
            for (int ai = 0; ai < 2; ++ai)
#pragma unroll
                for (int m = 0; m < 4; ++m) {
                    const float r = rs[ai][m]; const int row = row0 + ai * HALF + m * 16;
                    float s1 = 0.f, s2 = 0.f;
#pragma unroll
                    for (int bj = 0; bj < 2; ++bj) {
                        const f32x4 v0 = gelu4(acc[ai][bj][m][0] * r), v1 = gelu4(acc[ai][bj][m][1] * r);
                        st16_wt(GV + (size_t)row * A_WIDTH + ch0 + bj * HALF, pack8(v0, v1));
                        s1 += ((v0[0] + v0[1]) + (v0[2] + v0[3])) + ((v1[0] + v1[1]) + (v1[2] + v1[3]));
                        s2 += ((v0[0] * v0[0] + v0[1] * v0[1]) + (v0[2] * v0[2] + v0[3] * v0[3])) + ((v1[0] * v1[0] + v1[1] * v1[1]) + (v1[2] * v1[2] + v1[3] * v1[3]));
                    }
                    s1 += __shfl_xor(s1, 16); s1 += __shfl_xor(s1, 32); s2 += __shfl_xor(s2, 16); s2 += __shfl_xor(s2, 32);
                    if (fq == 0) *(f32x2*)(lnst + ((size_t)row * 32 + g * 4 + wc) * 2) = (f32x2){s1, s2};
                }
        }
    }
};
struct EpiKVQ {
    static constexpr bool PERM = true, AFTER_DRAIN = false; static constexpr int PBID = 32;
    bf16_t* Kb; bf16_t* Vb; bf16_t* Qb; bf16_t* SG; const LAS float* rtab; int kind0;
    __device__ __forceinline__ void operator()(const f32x4 (&acc)[2][2][4][2], const Unit& u, int wr, int wc, int fr, int fq) const {
        const int row0 = u.pm * BM + wr * 64 + fr;
        float rs[2][4]; load_rstd(rtab, u.ord, wr, fr, rs);
        const int kind = kind0 + (u.pn >> 2);
        bf16_t* base = kind == 0 ? Kb : kind == 1 ? Vb : kind == 2 ? Qb : SG;
        const int col0 = (u.pn & 3) * 256 + wc * 32 + 8 * fq;
#pragma unroll
        for (int ai = 0; ai < 2; ++ai)
#pragma unroll
            for (int m = 0; m < 4; ++m) {
                float r = rs[ai][m]; if (kind == 2) r *= QSCALE; const int row = row0 + ai * HALF + m * 16;
#pragma unroll
                for (int bj = 0; bj < 2; ++bj) {
                    f32x4 v0 = acc[ai][bj][m][0] * r, v1 = acc[ai][bj][m][1] * r;
                    if (kind == 3) { v0 = silu4(v0); v1 = silu4(v1); }
                    st16_wt(base + (size_t)row * D_MODEL + col0 + bj * HALF, pack8(v0, v1));
                }
            }
    }
};
struct EpiE {
    static constexpr bool PERM = true, AFTER_DRAIN = false; static constexpr int PBID = 33;
    bf16_t* E;
    __device__ __forceinline__ void operator()(const f32x4 (&acc)[2][2][4][2], const Unit& u, int wr, int wc, int fr, int fq) const {
        const int row0 = u.pm * BM + wr * 64 + fr, col0 = u.pn * BM + wc * 32 + 8 * fq;
#pragma unroll
        for (int ai = 0; ai < 2; ++ai)
#pragma unroll
            for (int m = 0; m < 4; ++m) { const int row = row0 + ai * HALF + m * 16;
#pragma unroll
                for (int bj = 0; bj < 2; ++bj) st16_wt(E + (size_t)row * D_MODEL + col0 + bj * HALF, pack8(acc[ai][bj][m][0], acc[ai][bj][m][1])); }
    }
};
__device__ __forceinline__ void unpack8(u32x4 w, f32x4& a, f32x4& b) {
    a = (f32x4){__uint_as_float(w.x << 16), __uint_as_float(w.x & 0xffff0000u), __uint_as_float(w.y << 16), __uint_as_float(w.y & 0xffff0000u)};
    b = (f32x4){__uint_as_float(w.z << 16), __uint_as_float(w.z & 0xffff0000u), __uint_as_float(w.w << 16), __uint_as_float(w.w & 0xffff0000u)};
}
struct EpiMix {
    static constexpr bool PERM = true, AFTER_DRAIN = false; static constexpr int PBID = 34;
    const bf16_t* hsrc; bf16_t* hdst; LAS unsigned char* lds;
    __device__ __forceinline__ void operator()(const f32x4 (&acc)[2][2][4][2], const Unit& u, int wr, int wc, int fr, int fq) const {
        const int row0 = u.pm * BM + wr * 64 + fr, col0 = u.pn * BM + wc * 32 + 8 * fq;
#pragma unroll
        for (int ai = 0; ai < 2; ++ai) {
            u32x4 hv[4][2];
#pragma unroll
            for (int m = 0; m < 4; ++m)
#pragma unroll
                for (int bj = 0; bj < 2; ++bj) hv[m][bj] = *(const u32x4*)(hsrc + (size_t)(row0 + ai * HALF + m * 16) * D_MODEL + col0 + bj * HALF);
#pragma unroll
            for (int m = 0; m < 4; ++m)
#pragma unroll
                for (int bj = 0; bj < 2; ++bj) { f32x4 a, b; unpack8(hv[m][bj], a, b);
                    st16_wt(hdst + (size_t)(row0 + ai * HALF + m * 16) * D_MODEL + col0 + bj * HALF, pack8(a + acc[ai][bj][m][0], b + acc[ai][bj][m][1])); }
            asm volatile("" ::: "memory");
        }
    }
};
struct EpiPle {
    static constexpr bool PERM = true, AFTER_DRAIN = false; static constexpr int PBID = 35;
    const bf16_t* h1; const bf16_t* E; bf16_t* hb; float* rowss; LAS unsigned char* lds;
    __device__ __forceinline__ void operator()(const f32x4 (&acc)[2][2][4][2], const Unit& u, int wr, int wc, int fr, int fq) const {
        const int row0 = u.pm * BM + wr * 64 + fr, col0 = u.pn * BM + wc * 32 + 8 * fq;
#pragma unroll
        for (int ai = 0; ai < 2; ++ai) {
            u32x4 hv[4][2], ev[4][2];
#pragma unroll
            for (int m = 0; m < 4; ++m)
#pragma unroll
                for (int bj = 0; bj < 2; ++bj) { const size_t o = (size_t)(row0 + ai * HALF + m * 16) * D_MODEL + col0 + bj * HALF; hv[m][bj] = *(const u32x4*)(h1 + o); if (m < 2) ev[m][bj] = *(const u32x4*)(E + o); }
#pragma unroll
            for (int m = 0; m < 4; ++m) { const int row = row0 + ai * HALF + m * 16; float ss = 0.f;
                if (m == 2) {
                    asm volatile("" ::: "memory");
#pragma unroll
                    for (int m2 = 2; m2 < 4; ++m2)
#pragma unroll
                        for (int bj = 0; bj < 2; ++bj) ev[m2][bj] = *(const u32x4*)(E + (size_t)(row0 + ai * HALF + m2 * 16) * D_MODEL + col0 + bj * HALF);
                }
#pragma unroll
                for (int bj = 0; bj < 2; ++bj) { f32x4 ha, hb_, ea, eb; unpack8(hv[m][bj], ha, hb_); unpack8(ev[m][bj], ea, eb);
                    const f32x4 x0 = ha + sigmoid4(acc[ai][bj][m][0]) * ea, x1 = hb_ + sigmoid4(acc[ai][bj][m][1]) * eb;
                    st16_wt(hb + (size_t)row * D_MODEL + col0 + bj * HALF, pack8(x0, x1));
                    ss += ((x0[0] * x0[0] + x0[1] * x0[1]) + (x0[2] * x0[2] + x0[3] * x0[3])) + ((x1[0] * x1[0] + x1[1] * x1[1]) + (x1[2] * x1[2] + x1[3] * x1[3])); }
                ss += __shfl_xor(ss, 16); ss += __shfl_xor(ss, 32);
                if (fq == 0) rowss[(size_t)row * 16 + u.pn * 4 + wc] = ss; }
            asm volatile("" ::: "memory");
        }
    }
};

template <class Epi, class Sched, bool ALIGN_EPI = false, bool SP2 = false>
__device__ __forceinline__ void gemm_phase(LAS unsigned char* lds, const Gemm g, const Sched& S, const Epi& E, unsigned stagger_ticks = 0) {
    int tid_l = threadIdx.x; asm volatile("" : "+v"(tid_l));
    const int tid = tid_l, wid = __builtin_amdgcn_readfirstlane(tid >> 6), lane = tid & 63, wr = wid >> 2, wc = wid & 3, fr = lane & 15, fq = lane >> 4;
    const int K = g.K, nt = K / BK;
    unsigned voffA[2], voffB[2];
#pragma unroll
    for (int i = 0; i < 2; ++i) { int R, C; stage_rc(tid * 16 + i * 8192, R, C); const int Rb = Epi::PERM ? ((R & ~31) + perm32(R & 31)) : R;
        voffA[i] = (unsigned)(R * K + C) * 2u; voffB[i] = (unsigned)(Rb * K + C) * 2u; }
    const size_t kstep = (size_t)(BK * 2);
    const size_t hstep = (size_t)HALF * K * 2;
    const size_t tstep = 2 * hstep;
    const unsigned ldsw = (unsigned)wid * 1024u;
    const int aoff = lds_byte(wr * 64 + fr, fq * 8), boff = lds_byte(wc * 32 + fr, fq * 8);
#define PG8_SA(b, h) (((b) * 2 + (h)) * HTB)
#define PG8_SB(b, h) ((4 + (b) * 2 + (h)) * HTB)
#define PG8_STAGE(bufoff, gbase, voff) do { _Pragma("unroll") for (int _i = 0; _i < 2; ++_i) \
        __builtin_amdgcn_global_load_lds((const unsigned*)((const char*)(gbase) + (voff)[_i]), (LAS unsigned*)(lds + (bufoff) + ldsw + _i * 8192), 16, 0, 0); } while (0)
#define PG8_LDA(dst, b, h) do { _Pragma("unroll") for (int m = 0; m < 4; ++m) _Pragma("unroll") for (int k = 0; k < 2; ++k) dst[m][k] = *(const LAS bf16x8*)(lds + PG8_SA(b, h) + aoff + m * 2048 + k * 1024); } while (0)
#define PG8_LDB(dst, b, h) do { _Pragma("unroll") for (int n = 0; n < 2; ++n) _Pragma("unroll") for (int k = 0; k < 2; ++k) dst[n][k] = *(const LAS bf16x8*)(lds + PG8_SB(b, h) + boff + n * 2048 + k * 1024); } while (0)
#define PG8_MMA(ai, bj, At, Bt) do { __builtin_amdgcn_s_setprio(1); _Pragma("unroll") for (int m = 0; m < 4; ++m) _Pragma("unroll") for (int n = 0; n < 2; ++n) _Pragma("unroll") for (int k = 0; k < 2; ++k) \
        acc[ai][bj][m][n] = __builtin_amdgcn_mfma_f32_16x16x32_bf16(Bt[n][k], At[m][k], acc[ai][bj][m][n], 0, 0, 0); __builtin_amdgcn_s_setprio(0); } while (0)
#define PG8_WAIT_V(n) asm volatile("s_waitcnt vmcnt(" #n ")" ::: "memory")
#define PG8_WAIT_L(n) asm volatile("s_waitcnt lgkmcnt(" #n ")" ::: "memory")
#define PG8_BAR __builtin_amdgcn_s_barrier()
#define PG8_SCHED __builtin_amdgcn_sched_barrier(0)
    Unit cur, nxt; int ui = 0;
    if (!S.next(0, cur)) return;
    if (stagger_ticks) { const unsigned long long t0_ = __builtin_amdgcn_s_memrealtime(); while ((unsigned)(__builtin_amdgcn_s_memrealtime() - t0_) < stagger_ticks) __builtin_amdgcn_s_sleep(4); }
    PB_BEGIN(23)
    PB_BEGIN(22)
    f32x4 acc[2][2][4][2];
#pragma unroll
    for (int a = 0; a < 2; ++a)
#pragma unroll
        for (int b = 0; b < 2; ++b)
#pragma unroll
            for (int m = 0; m < 4; ++m)
#pragma unroll
                for (int n = 0; n < 2; ++n) acc[a][b][m][n] = (f32x4){0.f, 0.f, 0.f, 0.f};
    bf16x8 At[4][2], B0[2][2], B1[2][2];
    const char* cA = (const char*)g.A + (size_t)cur.pm * tstep; const char* cB = (const char*)g.Bt + (size_t)cur.pn * tstep;
    S.a_ready(cur);
    if constexpr (SP2) {
        PG8_STAGE(PG8_SB(0, 0), cB, voffB); PG8_STAGE(PG8_SB(0, 1), cB + hstep, voffB); PG8_STAGE(PG8_SA(0, 0), cA, voffA); PG8_STAGE(PG8_SA(0, 1), cA + hstep, voffA);
        if (wr == 1) PG8_BAR;
        PG8_WAIT_V(2); PG8_BAR;
        PG8_STAGE(PG8_SB(1, 0), cB + kstep, voffB); PG8_STAGE(PG8_SA(1, 0), cA + kstep, voffA); PG8_STAGE(PG8_SB(1, 1), cB + hstep + kstep, voffB);
        PG8_WAIT_V(6); PG8_BAR;
    } else {
        PG8_STAGE(PG8_SB(0, 0), cB, voffB); PG8_STAGE(PG8_SA(0, 0), cA, voffA); PG8_STAGE(PG8_SB(0, 1), cB + hstep, voffB); PG8_STAGE(PG8_SA(0, 1), cA + hstep, voffA);
        if (wr == 1) PG8_BAR;
        PG8_WAIT_V(4); PG8_BAR;
        PG8_STAGE(PG8_SB(1, 0), cB + kstep, voffB); PG8_STAGE(PG8_SA(1, 0), cA + kstep, voffA); PG8_STAGE(PG8_SB(1, 1), cB + hstep + kstep, voffB);
        PG8_WAIT_V(6); PG8_BAR;
    }
    PB_END(22, lds, (blockIdx.x == 0 && tid == 7 * 64))
#pragma unroll 1
    for (;;) {
        const bool has_next = S.next(ui + 1, nxt);
        const char* nA = has_next ? (const char*)g.A + (size_t)nxt.pm * tstep : cA; const char* nB = has_next ? (const char*)g.Bt + (size_t)nxt.pn * tstep : cB;
#pragma unroll 1
        for (int t = 0; t < nt; t += 2) {
            const bool last = (t == nt - 2);
            const char* a1 = cA + (size_t)(t + 1) * kstep;
            const char* a2 = last ? nA : cA + (size_t)(t + 2) * kstep; const char* b2 = last ? nB : cB + (size_t)(t + 2) * kstep;
            const char* a3 = a2 + kstep; const char* b3 = b2 + kstep;
            if (last && has_next) S.a_ready(nxt);
            if constexpr (SP2) {
            PG8_LDB(B0, 0, 0); PG8_LDB(B1, 0, 1); PG8_SCHED; PG8_LDA(At, 0, 0); PG8_STAGE(PG8_SA(1, 1), a1 + hstep, voffA);
            PG8_WAIT_V(8); PG8_WAIT_L(0); PG8_BAR; PG8_MMA(0, 0, At, B0); PG8_MMA(0, 1, At, B1); PG8_BAR; PG8_SCHED;
            PG8_LDA(At, 0, 1); PG8_STAGE(PG8_SB(0, 0), b2, voffB); PG8_STAGE(PG8_SB(0, 1), b2 + hstep, voffB); PG8_STAGE(PG8_SA(0, 0), a2, voffA);
            PG8_WAIT_V(8); PG8_WAIT_L(0); PG8_BAR; PG8_MMA(1, 0, At, B0); PG8_MMA(1, 1, At, B1); PG8_BAR; PG8_SCHED;
            PG8_LDB(B0, 1, 0); PG8_LDB(B1, 1, 1); PG8_SCHED; PG8_LDA(At, 1, 0); PG8_STAGE(PG8_SA(0, 1), a2 + hstep, voffA);
            PG8_WAIT_V(8); PG8_WAIT_L(0); PG8_BAR; PG8_MMA(0, 0, At, B0); PG8_MMA(0, 1, At, B1); PG8_BAR; PG8_SCHED;
            PG8_LDA(At, 1, 1); PG8_STAGE(PG8_SB(1, 0), b3, voffB); PG8_STAGE(PG8_SB(1, 1), b3 + hstep, voffB); PG8_STAGE(PG8_SA(1, 0), a3, voffA);
            PG8_WAIT_V(8); PG8_WAIT_L(0); PG8_BAR; PG8_MMA(1, 0, At, B0); PG8_MMA(1, 1, At, B1); PG8_BAR; PG8_SCHED;
            } else {
            PG8_LDB(B0, 0, 0); PG8_SCHED; PG8_LDA(At, 0, 0); PG8_STAGE(PG8_SA(1, 1), a1 + hstep, voffA);
            PG8_WAIT_L(8); PG8_BAR; PG8_WAIT_L(0); PG8_MMA(0, 0, At, B0); PG8_BAR; PG8_SCHED;
            PG8_LDB(B1, 0, 1); PG8_STAGE(PG8_SB(0, 0), b2, voffB);
            PG8_BAR; PG8_WAIT_L(0); PG8_MMA(0, 1, At, B1); PG8_BAR;
            PG8_LDA(At, 0, 1); PG8_STAGE(PG8_SA(0, 0), a2, voffA);
            PG8_BAR; PG8_WAIT_L(0); PG8_MMA(1, 0, At, B0); PG8_BAR; PG8_SCHED;
            PG8_STAGE(PG8_SB(0, 1), b2 + hstep, voffB);
            PG8_WAIT_V(6); PG8_BAR; PG8_MMA(1, 1, At, B1); PG8_BAR;
            PG8_LDB(B0, 1, 0); PG8_SCHED; PG8_LDA(At, 1, 0); PG8_STAGE(PG8_SA(0, 1), a2 + hstep, voffA);
            PG8_WAIT_L(8); PG8_BAR; PG8_WAIT_L(0); PG8_MMA(0, 0, At, B0); PG8_BAR; PG8_SCHED;
            PG8_LDB(B1, 1, 1); PG8_STAGE(PG8_SB(1, 0), b3, voffB);
            PG8_BAR; PG8_WAIT_L(0); PG8_MMA(0, 1, At, B1); PG8_BAR;
            PG8_LDA(At, 1, 1); PG8_STAGE(PG8_SA(1, 0), a3, voffA);
            PG8_BAR; PG8_WAIT_L(0); PG8_MMA(1, 0, At, B0); PG8_BAR; PG8_SCHED;
            PG8_STAGE(PG8_SB(1, 1), b3 + hstep, voffB);
            PG8_WAIT_V(6); PG8_BAR; PG8_MMA(1, 1, At, B1); PG8_BAR;
            }
        }
        if constexpr (ALIGN_EPI) { if (wr == 0) PG8_BAR; }
        { unsigned long long pbt_e = 0; if (PROBE_ID == 21 || PROBE_ID == Epi::PBID) { __builtin_amdgcn_sched_barrier(0); pbt_e = __builtin_amdgcn_s_memrealtime(); __builtin_amdgcn_sched_barrier(0); }
          if constexpr (!Epi::AFTER_DRAIN) { E(acc, cur, wr, wc, fr, fq); S.done(cur); }
          if (PROBE_ID == 21 || PROBE_ID == Epi::PBID) { __builtin_amdgcn_sched_barrier(0); const unsigned pbd_ = (unsigned)(__builtin_amdgcn_s_memrealtime() - pbt_e); __builtin_amdgcn_sched_barrier(0); if (blockIdx.x == 0 && tid == 7 * 64) *PB_WORD(lds) = *PB_WORD(lds) + pbd_; } }
        if (!has_next) break;
#pragma unroll
        for (int a = 0; a < 2; ++a)
#pragma unroll
            for (int b = 0; b < 2; ++b)
#pragma unroll
                for (int m = 0; m < 4; ++m)
#pragma unroll
                    for (int n = 0; n < 2; ++n) acc[a][b][m][n] = (f32x4){0.f, 0.f, 0.f, 0.f};
        cur = nxt; cA = nA; cB = nB; ++ui;
        if constexpr (ALIGN_EPI) { if (wr == 1) PG8_BAR; }
    }
    PG8_WAIT_V(0);
    if constexpr (!ALIGN_EPI) { if (wr == 0) PG8_BAR; }
    PG8_BAR;
    PB_END(23, lds, (blockIdx.x == 0 && tid == 7 * 64))
#undef PG8_SA
#undef PG8_SB
#undef PG8_STAGE
#undef PG8_LDA
#undef PG8_LDB
#undef PG8_MMA
#undef PG8_WAIT_V
#undef PG8_WAIT_L
#undef PG8_BAR
#undef PG8_SCHED
}
}

typedef GAS unsigned gu32;
#define RLX_AGENT __ATOMIC_RELAXED, __HIP_MEMORY_SCOPE_AGENT
#define LDS_WAIT() asm volatile("s_waitcnt lgkmcnt(0)" ::: "memory")
#define VM_WAIT() asm volatile("s_waitcnt vmcnt(0)" ::: "memory")
__device__ __forceinline__ unsigned f2bf(float f) { unsigned u = __builtin_bit_cast(unsigned, f); return (u + 0x7fffu + ((u >> 16) & 1u)) >> 16; }
__device__ __forceinline__ unsigned pk2(float lo, float hi) { return f2bf(lo) | (f2bf(hi) << 16); }
__device__ __forceinline__ float bflo(unsigned w) { return __uint_as_float(w << 16); }
__device__ __forceinline__ float bfhi(unsigned w) { return __uint_as_float(w & 0xffff0000u); }

constexpr int CW_BAR = 4096;
#define XB_TMO      128
#define XB_XCNT(j)  (256  + 64 * (j))
#define XB_XSUB(j)  (1280 + 64 * (j))
#define XB_XGEN(j)  (2304 + 64 * (j))
#define XB_TOP      3328
#define XB_TOPGEN   3392
#define XCD_BAR_WORDS 3456
#define XB_SPIN_CAP (1u << 20)
__device__ __forceinline__ unsigned xb_ld(unsigned* p)              { return __hip_atomic_load(p, __ATOMIC_RELAXED, __HIP_MEMORY_SCOPE_AGENT); }
__device__ __forceinline__ unsigned xb_add(unsigned* p, unsigned v) { return __hip_atomic_fetch_add(p, v, __ATOMIC_RELAXED, __HIP_MEMORY_SCOPE_AGENT); }
__device__ __forceinline__ unsigned xb_xcc_id() { return (unsigned)__builtin_amdgcn_s_getreg((3 << 11) | 20) & 0xFu; }
#define XB_SPIN(cond, bar) do { unsigned _sp = 0; while (cond) { __builtin_amdgcn_s_sleep(1); \
    if ((++_sp & 255u) == 0u) { if (xb_ld(&(bar)[XB_TMO])) break; if (_sp > XB_SPIN_CAP) { atomicAdd(&(bar)[XB_TMO], 1u); break; } } } } while (0)
struct XcdBarrier { unsigned* bar; unsigned x; volatile LAS unsigned* st; };
__device__ __forceinline__ XcdBarrier xcd_barrier_post(unsigned* bar, volatile LAS unsigned* st) {
    XcdBarrier b; b.bar = bar; b.x = xb_xcc_id(); b.st = st;
    if (threadIdx.x == 0) (void)xb_add(&bar[XB_XCNT(b.x)], 1u);
    return b;
}
__device__ __forceinline__ void xcd_barrier_complete(unsigned* bar, unsigned x, unsigned& nloc, unsigned& nx) {
    const unsigned G = gridDim.x * gridDim.y * gridDim.z;
    unsigned sum, cnt, mine, sp = 0u;
    for (;;) {
        sum = 0u; cnt = 0u; mine = 0u;
#pragma unroll
        for (unsigned j = 0; j < 16; ++j) { const unsigned c = xb_ld(&bar[XB_XCNT(j)]); sum += c; cnt += (c > 0u) ? 1u : 0u; mine = (j == x) ? c : mine; }
        if (sum == G) break;
        __builtin_amdgcn_s_sleep(1);
        if ((++sp & 255u) == 0u) { if (xb_ld(&bar[XB_TMO])) break; if (sp > XB_SPIN_CAP) { atomicAdd(&bar[XB_TMO], 1u); break; } }
    }
    nloc = mine > 0u ? mine : 1u; nx = cnt > 0u ? cnt : 1u;
}
__device__ __forceinline__ void xcd_barrier(const XcdBarrier& b) {
    asm volatile("s_waitcnt vmcnt(0)" ::: "memory");
    __syncthreads();
    if (threadIdx.x == 0) {
        unsigned* bar = b.bar; unsigned bx_ = b.x;
        asm volatile("" : "+s"(bar), "+s"(bx_));
        __builtin_amdgcn_s_waitcnt(0);
        unsigned nloc = b.st[0], nx = b.st[1];
        if (nloc == 0u) { xcd_barrier_complete(bar, bx_, nloc, nx); b.st[0] = nloc; b.st[1] = nx; }
        const unsigned old = xb_add(&bar[XB_XSUB(bx_)], 1u);
        const unsigned gen = old / nloc;
        if (old + 1u == (gen + 1u) * nloc) {
            __builtin_amdgcn_fence(__ATOMIC_RELEASE, "agent");
            asm volatile("s_waitcnt vmcnt(0)" ::: "memory");
            const unsigned og = xb_add(&bar[XB_TOP], 1u);
            const unsigned tg = og / nx;
            if (og + 1u == (tg + 1u) * nx) xb_add(&bar[XB_TOPGEN], 1u);
            else XB_SPIN(xb_ld(&bar[XB_TOPGEN]) == tg, bar);
            __builtin_amdgcn_fence(__ATOMIC_ACQUIRE, "agent");
            xb_add(&bar[XB_XGEN(bx_)], 1u);
            asm volatile("s_waitcnt vmcnt(0)" ::: "memory");
        } else {
            XB_SPIN(xb_ld(&bar[XB_XGEN(bx_)]) == gen, bar);
            __builtin_amdgcn_fence(__ATOMIC_ACQUIRE, "agent");
            asm volatile("s_waitcnt vmcnt(0)" ::: "memory");
        }
    }
    __syncthreads();
}

struct Args {
    const float* x; const float* p; const float* norm_g; const float* a_w_in; const float* a_ln_g; const float* a_ln_b; const float* a_w_s; const float* a_b_s; const float* a_w_out;
    const float* kv_norm_g; const float* w_kv; const float* b_w_in; const float* b_w_out; const float* ple_w; const float* ple_gate_w; const float* final_g;
    float* out; unsigned char* ws;
};

__device__ __forceinline__ float wave_sum(float v) {
#pragma unroll
    for (int o = 1; o < 64; o <<= 1) v += __shfl_xor(v, o);
    return v;
}

__device__ __forceinline__ int src_col(int mode, int n, int col_off) {
    if (mode == 0) return n + col_off;
    if (n < 4096) { const int t = n >> 8, j = n & 255; return j < 128 ? 128 * t + j : 4096 + 128 * t + (j - 128); }
    return 2048 + (n - 4096);
}
__device__ __forceinline__ void transpose_item(const float* W, int K, int Nsrc, int mode, int col_off, const float* scale, bf16_t* WT, LAS float* scr, int item, int lane, int nblk) {
    const int kb = item / nblk, nb = item % nblk, k0 = 64 * kb, n0 = 32 * nb, s0 = src_col(mode, n0, col_off);
    const int kl = lane >> 3, n4 = 4 * (lane & 7);
    f32x4 v[8];
#pragma unroll
    for (int i = 0; i < 8; ++i) v[i] = *(const f32x4*)(W + (size_t)(k0 + 8 * i + kl) * Nsrc + s0 + n4);
#pragma unroll
    for (int i = 0; i < 8; ++i) { const int kk = 8 * i + kl; const float sc = scale ? scale[k0 + kk] : 1.0f; LAS float* d = scr + kk * 33 + n4;
        d[0] = v[i][0] * sc; d[1] = v[i][1] * sc; d[2] = v[i][2] * sc; d[3] = v[i][3] * sc; }
    LDS_WAIT(); asm volatile("" ::: "memory");
    const int c = lane >> 3;
#pragma unroll
    for (int j = 0; j < 4; ++j) { const int n = (lane & 7) + 8 * j; const LAS float* s = scr + (8 * c) * 33 + n;
        u32x4 o; o.x = pk2(s[0 * 33], s[1 * 33]); o.y = pk2(s[2 * 33], s[3 * 33]); o.z = pk2(s[4 * 33], s[5 * 33]); o.w = pk2(s[6 * 33], s[7 * 33]);
        pg8::st16_wt(WT + (size_t)(n0 + n) * K + k0 + 8 * c, o); }
    LDS_WAIT(); asm volatile("" ::: "memory");
}
#define TJOB(W_, K_, Nsrc_, ndst_, mode_, coff_, scale_, WT_) do { const int nblk_ = (ndst_) / 32, items_ = ((K_) / 64) * nblk_; \
        for (int it_ = ((gw - jbase) % NGW + NGW) % NGW; it_ < items_; it_ += NGW) transpose_item((W_), (K_), (Nsrc_), (mode_), (coff_), (scale_), (WT_), scr, it_, lane, nblk_); \
        jbase = (jbase + items_) % NGW; } while (0)

__device__ __forceinline__ void convert_p(const float* src, bf16_t* dst, int gtid_in, int gthreads) {
    int gtid = gtid_in; asm volatile("" : "+v"(gtid));
    const int n8 = M * PLE_DIM / 8;
    for (int i = gtid; i < n8; i += gthreads) { const f32x4 a = *(const f32x4*)(src + (size_t)i * 8), b = *(const f32x4*)(src + (size_t)i * 8 + 4);
        u32x4 o; o.x = pk2(a[0], a[1]); o.y = pk2(a[2], a[3]); o.z = pk2(b[0], b[1]); o.w = pk2(b[2], b[3]); pg8::st16_wt(dst + (size_t)i * 8, o); }
}

__device__ __forceinline__ s16x4 mx_vtr(const LAS unsigned char* p) { return __builtin_bit_cast(s16x4, __builtin_amdgcn_ds_read_tr16_b64_v4i16((LAS s16x4*)p)); }
constexpr int MX_WM = 0, MX_LD = 136, MX_RSV = 544, MX_VT = 128 * MX_LD * 2, MX_ST = MX_VT + 128 * MX_RSV, MX_BS = MX_ST + 2 * 128 * 8, MX_END = MX_BS + 128 * 4;
static_assert(MX_END <= RING_BYTES, "mix LDS map");
__device__ __forceinline__ void mix_phase(LAS unsigned char* lds, int vcu, const float* wsm_l  , const float* bs_l  , const float* lng, const float* lnb,
                                          const bf16_t* GV, const bf16_t* UG, bf16_t* Yo, size_t ymask, const float* lnst, int tid_in) {
    int tid = tid_in; asm volatile("" : "+v"(tid));
    const int lane = tid & 63, wid = tid >> 6, g = vcu & 7, nb0 = vcu >> 3;
    LAS f32x2* ST = (LAS f32x2*)(lds + MX_ST); LAS float* BS = (LAS float*)(lds + MX_BS);
    { const float* wsm = wsm_l + (size_t)g * 128 * 128;
#pragma unroll
      for (int i = 0; i < 4; ++i) { const int idx = tid + 512 * i, t = idx >> 4, s8 = idx & 15;
        f32x4 a = *(const f32x4*)(wsm + t * 128 + s8 * 8), b = *(const f32x4*)(wsm + t * 128 + s8 * 8 + 4);
        if (t < 64 && s8 >= 8) { a = (f32x4){0.f, 0.f, 0.f, 0.f}; b = a; }
        u32x4 o; o.x = pk2(a[0], a[1]); o.y = pk2(a[2], a[3]); o.z = pk2(b[0], b[1]); o.w = pk2(b[2], b[3]);
        *(LAS u32x4*)(lds + MX_WM + t * (MX_LD * 2) + s8 * 16) = o; }
      if (tid < 128) BS[tid] = bs_l[g * 128 + tid]; }
    const int c8 = tid & 31, srow0 = tid >> 5;
    float lg[8], lb[8];
    { const f32x4 ga = *(const f32x4*)(lng + g * 256 + c8 * 8), gb = *(const f32x4*)(lng + g * 256 + c8 * 8 + 4), ba = *(const f32x4*)(lnb + g * 256 + c8 * 8), bb = *(const f32x4*)(lnb + g * 256 + c8 * 8 + 4);
#pragma unroll
      for (int e = 0; e < 4; ++e) { lg[e] = ga[e]; lg[4 + e] = gb[e]; lb[e] = ba[e]; lb[4 + e] = bb[e]; } }
    u32x4 gvr[8];
#define MX_LOADGV(nb_) do { _Pragma("unroll") for (int i_ = 0; i_ < 8; ++i_) gvr[i_] = *(const u32x4*)(GV + (size_t)((nb_) * 128 + srow0 + 16 * i_) * A_WIDTH + g * 256 + c8 * 8); } while (0)
#define MX_STATS(nb_, buf_) do { if (tid < 128) { const f32x4* p_ = (const f32x4*)(lnst + (size_t)((nb_) * 128 + tid) * 64); float s1_ = 0.f, s2_ = 0.f; \
        _Pragma("unroll") for (int i_ = 0; i_ < 16; ++i_) { const f32x4 v_ = p_[i_]; s1_ += v_[0] + v_[2]; s2_ += v_[1] + v_[3]; } \
        const float mean_ = s1_ * (1.0f / A_WIDTH), var_ = fmaxf(s2_ * (1.0f / A_WIDTH) - mean_ * mean_, 0.f); ST[(buf_) * 128 + tid] = (f32x2){mean_, 1.0f / sqrtf(var_ + EPS)}; } } while (0)
    MX_STATS(nb0, 0); MX_LOADGV(nb0);
    __syncthreads();
    const int fr = lane & 15, fq = lane >> 4;
#pragma unroll 1
    for (int k = 0; k < 4; ++k) {
        const int nb = nb0 + 32 * k;
        { const int wbk = c8 >> 2, m = c8 & 3;
#pragma unroll
          for (int i = 0; i < 8; ++i) { const int srow = srow0 + 16 * i; const f32x2 st = ST[(k & 1) * 128 + srow]; const u32x4 w = gvr[i];
            const float v[8] = {bflo(w.x), bfhi(w.x), bflo(w.y), bfhi(w.y), bflo(w.z), bfhi(w.z), bflo(w.w), bfhi(w.w)};
            float y[8];
#pragma unroll
            for (int e = 0; e < 8; ++e) y[e] = (v[e] - st.x) * st.y * lg[e] + lb[e];
            u32x2 lo, hi2; lo.x = pk2(y[0], y[1]); lo.y = pk2(y[2], y[3]); hi2.x = pk2(y[4], y[5]); hi2.y = pk2(y[6], y[7]);
            *(LAS u32x2*)(lds + MX_VT + srow * MX_RSV + wbk * 64 + m * 8) = lo; *(LAS u32x2*)(lds + MX_VT + srow * MX_RSV + wbk * 64 + 32 + m * 8) = hi2; } }
        if (k < 3) MX_LOADGV(nb + 32);
        __syncthreads();
        f32x4 acc[2][8];
#pragma unroll
        for (int ct = 0; ct < 2; ++ct)
#pragma unroll
            for (int tt = 0; tt < 8; ++tt) acc[ct][tt] = (f32x4){0.f, 0.f, 0.f, 0.f};
        const LAS unsigned char* vta = lds + MX_VT + (8 * fq + (fr >> 2)) * MX_RSV + wid * 64 + (fr & 3) * 8;
#pragma unroll
        for (int ks = 0; ks < 4; ++ks) {
            bf16x8 af[2];
#pragma unroll
            for (int ct = 0; ct < 2; ++ct) { const s16x4 lo = mx_vtr(vta + ks * 32 * MX_RSV + ct * 32), hh = mx_vtr(vta + ks * 32 * MX_RSV + ct * 32 + 4 * MX_RSV);
                af[ct] = (bf16x8){lo[0], lo[1], lo[2], lo[3], hh[0], hh[1], hh[2], hh[3]}; }
#pragma unroll
            for (int tt = 0; tt < 8; ++tt) {
                if (tt < 4 && ks >= 2) continue;
                const bf16x8 bfr = *(const LAS bf16x8*)(lds + MX_WM + (tt * 16 + fr) * (MX_LD * 2) + ks * 64 + fq * 16);
#pragma unroll
                for (int ct = 0; ct < 2; ++ct) acc[ct][tt] = __builtin_amdgcn_mfma_f32_16x16x32_bf16(af[ct], bfr, acc[ct][tt], 0, 0, 0);
            }
        }
#pragma unroll
        for (int tt = 0; tt < 8; ++tt) { const int t = tt * 16 + fr; const float b = BS[t];
            const size_t eo = (size_t)(nb * 128 + t) * A_WIDTH + g * 256 + wid * 32 + 8 * fq;
            const u32x4 w = *(const u32x4*)(UG + eo); const f32x4 a0 = acc[0][tt], a1 = acc[1][tt];
            u32x4 o; o.x = pk2(bflo(w.x) * (a0[0] + b), bfhi(w.x) * (a0[1] + b)); o.y = pk2(bflo(w.y) * (a0[2] + b), bfhi(w.y) * (a0[3] + b));
            o.z = pk2(bflo(w.z) * (a1[0] + b), bfhi(w.z) * (a1[1] + b)); o.w = pk2(bflo(w.w) * (a1[2] + b), bfhi(w.w) * (a1[3] + b));
            pg8::st16_wt(Yo + (eo & ymask), o); }
        if (k < 3) MX_STATS(nb + 32, (k + 1) & 1);
        __syncthreads();
    }
#undef MX_LOADGV
#undef MX_STATS
}

constexpr int AT_K = 0, AT_V = 32768, AT_KV_BYTES = 16384, AT_Q = 65536;
__device__ __forceinline__ int crow(int r, int hi) { return (r & 3) + 8 * (r >> 2) + 4 * hi; }
__device__ __forceinline__ s16x4 vtr(const LAS unsigned char* p) { return __builtin_bit_cast(s16x4, __builtin_amdgcn_ds_read_tr16_b64_v4i16((LAS s16x4*)p)); }
__device__ __forceinline__ float vmaxf(float a, float b) { float r; asm("v_max_f32_e32 %0, %1, %2" : "=v"(r) : "v"(a), "v"(b)); return r; }
template <int LITE = 0> __device__ __forceinline__ float sp_tail(float z) { if constexpr (LITE & 1) return 1.0f - __builtin_fabsf(z) * 0.01f; else return __builtin_amdgcn_logf(1.0f + __builtin_amdgcn_exp2f(-__builtin_fabsf(z))); }
template <int LITE = 0> __device__ __forceinline__ float ex2(float x) { if constexpr (LITE & 1) return x * 0.001f; else return __builtin_amdgcn_exp2f(x); }
struct AttnRegs { f32x16 o[4]; f32x16 y0, y1; float R, zf; };

template <bool QK, bool PV, bool DQK, bool DPV, int LITE = 0>
__device__ __forceinline__ void attn_step(AttnRegs& a, const LAS unsigned char* Kt, const LAS unsigned char* Vt, const LAS unsigned char* Qs,
                                          int lane, int qrelQK, int qrelPV, const bf16x8 (&ntri)[2], const bf16x8 none, LAS unsigned char* pb_lds, bool pb_on) {
    const int r32 = lane & 31, hi = lane >> 5;
    f32x16 zN0, zN1; u32x4 pw[4], xw[4];
    float tot = 0.f;
    if constexpr (PV) { tot = a.y0[0] - a.zf; const auto rr = __builtin_amdgcn_permlane32_swap(__float_as_uint(tot), __float_as_uint(tot), false, false); tot = __uint_as_float(rr[0]); }
    PB_BEGIN(2)
    bf16x8 kf[3][3];
    const int swz = r32 & 15;
#define AT_KLOAD(ds_) do { const int off_ = r32 * 256 + (((2 * (ds_) + hi) ^ swz) << 4); \
        if constexpr (LITE & 4) { kf[(ds_) % 3][0] = ntri[0]; kf[(ds_) % 3][1] = ntri[1]; kf[(ds_) % 3][2] = none; } else { \
        kf[(ds_) % 3][0] = *(const LAS bf16x8*)(Kt + off_); kf[(ds_) % 3][1] = *(const LAS bf16x8*)(Kt + off_ + 32 * 256); kf[(ds_) % 3][2] = *(const LAS bf16x8*)(Qs + off_); } } while (0)
    if constexpr (QK) {
#pragma unroll
        for (int r = 0; r < 16; ++r) { zN0[r] = 0.f; zN1[r] = 0.f; }
        AT_KLOAD(0); AT_KLOAD(1);
    }
#pragma unroll
    for (int ds = 0; ds < 8; ++ds) {
        if constexpr (QK) {
            if (ds + 2 < 8) AT_KLOAD(ds + 2);
            if constexpr (LITE & 8) { zN0[ds] += __builtin_bit_cast(f32x4, kf[ds % 3][0])[0] * __builtin_bit_cast(f32x4, kf[ds % 3][2])[1]; zN1[ds] += __builtin_bit_cast(f32x4, kf[ds % 3][1])[2] * __builtin_bit_cast(f32x4, kf[ds % 3][2])[3]; } else {
            zN0 = __builtin_amdgcn_mfma_f32_32x32x16_bf16(kf[ds % 3][0], kf[ds % 3][2], zN0, 0, 0, 0);
            zN1 = __builtin_amdgcn_mfma_f32_32x32x16_bf16(kf[ds % 3][1], kf[ds % 3][2], zN1, 0, 0, 0); }
        }
        if constexpr (PV) {
            const int r = 2 * ds;
            float a0, a1, b0, b1; if constexpr (LITE & 32) { a0 = a.y0[r]; a1 = a.y0[r + 1]; b0 = a.y1[r]; b1 = a.y1[r + 1]; } else { a0 = ex2<LITE>(a.y0[r] + a.R); a1 = ex2<LITE>(a.y0[r + 1] + a.R); b0 = ex2<LITE>(a.y1[r] + a.R); b1 = ex2<LITE>(a.y1[r + 1] + a.R); }
            if constexpr (DPV) { const int k0 = crow(r, hi), k1 = crow(r + 1, hi);
                a0 = (k0 < qrelPV) ? a0 : 0.f; a1 = (k1 < qrelPV) ? a1 : 0.f; b0 = (k0 + 32 < qrelPV) ? b0 : 0.f; b1 = (k1 + 32 < qrelPV) ? b1 : 0.f; }
            pw[r >> 3][(r >> 1) & 3] = pg8::cvt_pk_bf16(a0, a1); pw[2 + (r >> 3)][(r >> 1) & 3] = pg8::cvt_pk_bf16(b0, b1);
        }
        __builtin_amdgcn_sched_barrier(0);
    }
#undef AT_KLOAD
    if constexpr (PV) a.R += tot;
    PB_END(2, pb_lds, pb_on)
    PB_BEGIN(3)
    const LAS unsigned char* vb = Vt + ((lane >> 4) & 1) * 32 + (lane & 3) * 8 + (4 * hi + ((lane & 15) >> 2)) * 64;
    s16x4 vl[3], vh[3];
#define AT_VLOAD(i_) do { if constexpr (LITE & 4) { vl[(i_) % 3] = (s16x4){ntri[0][0], ntri[0][1], ntri[0][2], ntri[0][3]}; vh[(i_) % 3] = (s16x4){ntri[1][4], ntri[1][5], ntri[1][6], ntri[1][7]}; } else { \
        vl[(i_) % 3] = vtr(vb + ((i_) >> 2) * 4096 + ((i_) & 3) * 1024); vh[(i_) % 3] = vtr(vb + ((i_) >> 2) * 4096 + ((i_) & 3) * 1024 + 512); } } while (0)
    if constexpr (PV) { AT_VLOAD(0); AT_VLOAD(1); }
    float zfirst = 0.f;
#pragma unroll
    for (int i = 0; i < 16; ++i) {
        const int d = i >> 2, ks = i & 3;
        if constexpr (PV) {
            if (i + 2 < 16) AT_VLOAD(i + 2);
            const s16x4 lo = vl[i % 3], hh = vh[i % 3];
            const bf16x8 vf = (bf16x8){lo[0], lo[1], lo[2], lo[3], hh[0], hh[1], hh[2], hh[3]};
            if constexpr (LITE & 8) a.o[d][i & 15] += __builtin_bit_cast(f32x4, vf)[0] * __uint_as_float(pw[ks][i & 3]); else
            a.o[d] = __builtin_amdgcn_mfma_f32_32x32x16_bf16(__builtin_bit_cast(bf16x8, pw[ks]), vf, a.o[d], 0, 0, 0);
        }
        if constexpr (QK) {
            if (i == 0) zfirst = zN0[0];
            if (i < 8) { const int r = 2 * i;
                float z0 = zN0[r], z1 = zN0[r + 1]; asm volatile("" : "+v"(z0), "+v"(z1));
                float s0, s1; if constexpr (LITE & 32) { s0 = z0; s1 = z1; } else { s0 = vmaxf(z0, 0.f) + sp_tail<LITE>(z0); s1 = vmaxf(z1, 0.f) + sp_tail<LITE>(z1); }
                if constexpr (DQK) { s0 = (crow(r, hi) < qrelQK) ? s0 : 0.f; s1 = (crow(r + 1, hi) < qrelQK) ? s1 : 0.f; }
                if constexpr (!(LITE & 32)) { z0 -= s0; z1 -= s1; }
                unsigned xp = pg8::cvt_pk_bf16(s0, s1); asm volatile("" : "+v"(z0), "+v"(z1), "+v"(xp));
                zN0[r] = z0; zN0[r + 1] = z1; xw[r >> 3][(r >> 1) & 3] = xp;
            } else { const int r = 2 * (i - 8);
                float z0 = zN1[r], z1 = zN1[r + 1]; asm volatile("" : "+v"(z0), "+v"(z1));
                float s0, s1; if constexpr (LITE & 32) { s0 = z0; s1 = z1; } else { s0 = vmaxf(z0, 0.f) + sp_tail<LITE>(z0); s1 = vmaxf(z1, 0.f) + sp_tail<LITE>(z1); }
                if constexpr (DQK) { s0 = (crow(r, hi) + 32 < qrelQK) ? s0 : 0.f; s1 = (crow(r + 1, hi) + 32 < qrelQK) ? s1 : 0.f; }
                if constexpr (!(LITE & 32)) { z0 -= s0; z1 -= s1; }
                unsigned xp = pg8::cvt_pk_bf16(s0, s1); asm volatile("" : "+v"(z0), "+v"(z1), "+v"(xp));
                zN1[r] = z0; zN1[r + 1] = z1; xw[2 + (r >> 3)][(r >> 1) & 3] = xp;
            }
        }
        __builtin_amdgcn_sched_barrier(0);
    }
#undef AT_VLOAD
    PB_END(3, pb_lds, pb_on)
    PB_BEGIN(4)
    if constexpr (QK) {
        const bf16x8 x00 = __builtin_bit_cast(bf16x8, xw[0]), x01 = __builtin_bit_cast(bf16x8, xw[1]), x10 = __builtin_bit_cast(bf16x8, xw[2]), x11 = __builtin_bit_cast(bf16x8, xw[3]);
        zN0 = __builtin_amdgcn_mfma_f32_32x32x16_bf16(ntri[0], x00, zN0, 0, 0, 0);
        zN1 = __builtin_amdgcn_mfma_f32_32x32x16_bf16(ntri[0], x10, zN1, 0, 0, 0);
        zN0 = __builtin_amdgcn_mfma_f32_32x32x16_bf16(ntri[1], x01, zN0, 0, 0, 0);
        zN1 = __builtin_amdgcn_mfma_f32_32x32x16_bf16(ntri[1], x11, zN1, 0, 0, 0);
        zN0 = __builtin_amdgcn_mfma_f32_32x32x16_bf16(none, x10, zN0, 0, 0, 0);
        zN0 = __builtin_amdgcn_mfma_f32_32x32x16_bf16(none, x11, zN0, 0, 0, 0);
        a.y0 = zN0; a.y1 = zN1; a.zf = zfirst;
    }
    PB_END(4, pb_lds, pb_on)
}

template <int LITE = 0>
__device__ __forceinline__ void attn_unit(LAS unsigned char* lds, int b, int h, int qb, const bf16_t* Qb, const bf16_t* Kb, const bf16_t* Vb, const bf16_t* SG, bf16_t* OG, int tid_in) {
    int tid = tid_in; asm volatile("" : "+v"(tid));
    const int lane = tid & 63, wid = __builtin_amdgcn_readfirstlane(tid >> 6), r32 = lane & 31, hi = lane >> 5;
    const size_t rowbase = (size_t)b * SEQ;
    const int R0 = 256 * qb + 32 * wid;
    const int NT = 4 * qb + 4, jd = 4 * qb + (wid >> 1);
    const bool pb_on = (PROBE_ID != 0) && LITE == 0 && blockIdx.x == 0 && wid == 7 && lane == 0;
    PB_BEGIN(6)
    LAS unsigned char* Qs = lds + AT_Q + wid * 8192;
#pragma unroll
    for (int i = 0; i < 8; ++i) { const int p = lane + 64 * i, row = p >> 4, ch = p & 15;
        *(LAS u32x4*)(Qs + row * 256 + ((ch ^ (row & 15)) << 4)) = *(const u32x4*)(Qb + (rowbase + R0 + row) * D_MODEL + h * HEAD_DIM + ch * 8); }
    bf16x8 ntri[2], none;
#pragma unroll
    for (int s = 0; s < 2; ++s)
#pragma unroll
        for (int e = 0; e < 8; ++e) { const int j = 16 * s + 8 * (e >> 2) + 4 * hi + (e & 3); ntri[s][e] = (j > r32) ? (short)0xBF80 : (short)0; }
#pragma unroll
    for (int e = 0; e < 8; ++e) none[e] = (short)0xBF80;
    AttnRegs a;
#pragma unroll
    for (int d = 0; d < 4; ++d)
#pragma unroll
        for (int r = 0; r < 16; ++r) a.o[d][r] = 0.f;
#pragma unroll
    for (int r = 0; r < 16; ++r) { a.y0[r] = 0.f; a.y1[r] = 0.f; }
    a.R = 0.f; a.zf = 0.f;
    const bf16_t* Kh = Kb + rowbase * D_MODEL + h * HEAD_DIM; const bf16_t* Vh = Vb + rowbase * D_MODEL + h * HEAD_DIM;
    const bf16_t* ksrc[2]; const bf16_t* vsrc[2];
#pragma unroll
    for (int i = 0; i < 2; ++i) { const int pi = 2 * wid + i, key = 4 * pi + (lane >> 4), c = (lane & 15) ^ (key & 15);
        ksrc[i] = Kh + (size_t)key * D_MODEL + c * 8;
        const int vkey = 16 * (pi & 3) + (lane >> 2);
        vsrc[i] = Vh + (size_t)vkey * D_MODEL + (pi >> 2) * 32 + (lane & 3) * 8; }
    const unsigned ldsbase = (unsigned)(size_t)lds;
#define AT_GLDS(src_, dst_) do { unsigned keep_; asm volatile("s_mov_b32 %0, m0\n\ts_mov_b32 m0, %2\n\ts_nop 0\n\tglobal_load_lds_dwordx4 %1, off\n\ts_mov_b32 m0, %0" : "=&s"(keep_) : "v"(src_), "s"(dst_) : "memory"); } while (0)
#define AT_DMA_K(jt_, slot_) do { _Pragma("unroll") for (int i_ = 0; i_ < 2; ++i_) \
        AT_GLDS(ksrc[i_] + (size_t)(jt_) * 64 * D_MODEL, (unsigned)__builtin_amdgcn_readfirstlane(ldsbase + AT_K + (slot_) * AT_KV_BYTES + (2 * wid + i_) * 1024)); } while (0)
#define AT_DMA_V(jt_, slot_) do { _Pragma("unroll") for (int i_ = 0; i_ < 2; ++i_) \
        AT_GLDS(vsrc[i_] + (size_t)(jt_) * 64 * D_MODEL, (unsigned)__builtin_amdgcn_readfirstlane(ldsbase + AT_V + (slot_) * AT_KV_BYTES + (2 * wid + i_) * 1024)); } while (0)
#define AT_WAIT_BAR() do { PB_BEGIN(1) asm volatile("s_waitcnt vmcnt(0) lgkmcnt(0)" ::: "memory"); __builtin_amdgcn_s_barrier(); asm volatile("" ::: "memory"); PB_END(1, lds, pb_on) } while (0)
    AT_DMA_K(NT - 1, (NT - 1) & 1);
    PB_END(6, lds, pb_on)
    AT_WAIT_BAR();
#define AT_PRE(t_) do { PB_BEGIN(5) if constexpr (!(LITE & 16)) { if ((t_) >= 2) AT_DMA_K((t_) - 2, (t_) & 1); if ((t_) >= 1) AT_DMA_V((t_) - 1, ((t_) - 1) & 1); } PB_END(5, lds, pb_on) } while (0)
#define AT_KT(t_) (lds + AT_K + (((t_) - 1) & 1) * AT_KV_BYTES)
#define AT_VT(t_) (lds + AT_V + ((t_) & 1) * AT_KV_BYTES)
    int t = NT;
#pragma unroll 1
    for (; t > jd + 1; --t) { AT_PRE(t); AT_WAIT_BAR(); }
    { AT_PRE(t);
      if constexpr (!(LITE & 2)) attn_step<true, true, true, true, LITE>(a, AT_KT(t), AT_VT(t), Qs, lane, R0 - 64 * (t - 1) + r32, -(1 << 20), ntri, none, lds, pb_on);
      AT_WAIT_BAR(); --t; }
    { AT_PRE(t);
      if constexpr (!(LITE & 2)) attn_step<true, true, true, true, LITE>(a, AT_KT(t), AT_VT(t), Qs, lane, 1 << 20, R0 - 64 * t + r32, ntri, none, lds, pb_on);
      AT_WAIT_BAR(); --t; }
#pragma unroll 1
    for (; t >= 0; --t) { AT_PRE(t);
      if constexpr (!(LITE & 2)) attn_step<true, true, false, false, LITE>(a, AT_KT(t), AT_VT(t), Qs, lane, 0, 0, ntri, none, lds, pb_on);
      AT_WAIT_BAR(); }
#undef AT_PRE
#undef AT_KT
#undef AT_VT
#undef AT_DMA_K
#undef AT_GLDS
#undef AT_DMA_V
#undef AT_WAIT_BAR
    PB_BEGIN(7)
    { const bf16_t* SGw = SG + (rowbase + R0) * D_MODEL + h * HEAD_DIM; bf16_t* OGw = OG + (rowbase + R0) * D_MODEL + h * HEAD_DIM;
      int lane_e = lane; asm volatile("" : "+v"(lane_e) :: "memory");
      const int er = lane_e >> 4, ec = lane_e & 15;
#pragma unroll
      for (int hb = 0; hb < 2; ++hb) { u32x4 gt[4];
#pragma unroll
          for (int i = 0; i < 4; ++i) gt[i] = *(const u32x4*)(SGw + (size_t)(16 * hb + 4 * i + er) * D_MODEL + ec * 8);
#pragma unroll
          for (int i = 0; i < 4; ++i) *(LAS u32x4*)(Qs + (16 * hb + 4 * i + er) * 256 + ec * 16) = gt[i];
          asm volatile("" ::: "memory"); }
#pragma unroll
      for (int r = 0; r < 16; ++r) { LAS unsigned short* sp = (LAS unsigned short*)(Qs + crow(r, hi) * 256 + r32 * 2);
#pragma unroll
          for (int d = 0; d < 4; ++d) { const float gsv = __uint_as_float((unsigned)sp[d * 32] << 16); sp[d * 32] = (unsigned short)f2bf(a.o[d][r] * gsv); } }
#pragma unroll
      for (int i = 0; i < 8; ++i) { const u32x4 v = *(const LAS u32x4*)(Qs + (4 * i + er) * 256 + ec * 16);
          pg8::st16_wt(OGw + (size_t)(4 * i + er) * D_MODEL + ec * 8, v); } }
    if (PROBE_ID == 7) asm volatile("s_waitcnt vmcnt(0)" ::: "memory");
    PB_END(7, lds, pb_on)
}

__global__ void __launch_bounds__(NWAVES * 64, 2) yoco_fwd(Args args) {
    extern __shared__ __attribute__((aligned(16))) unsigned char lds_raw[];
    LAS unsigned char* lds = (LAS unsigned char*)lds_raw;
    volatile LAS unsigned* MISC = (volatile LAS unsigned*)(lds + MISC_OFF);
    const int tid = threadIdx.x, lane = tid & 63, wave = __builtin_amdgcn_readfirstlane(tid >> 6);
    const int G = gridDim.x; const int bx = blockIdx.x; const int vcu = (G % 8 == 0) ? (bx % 8) * (G / 8) + bx / 8 : bx;
    unsigned char* ws = args.ws;
    gu32* ctl = (gu32*)(ws + WS_CTL);
    for (int u = tid; u < (LDS_BYTES - LDSCTL_OFF) / 4; u += NWAVES * 64) ((LAS unsigned*)(lds + LDSCTL_OFF))[u] = 0u;
    __syncthreads();
    XcdBarrier bar = xcd_barrier_post((unsigned*)(ctl + CW_BAR), MISC + 8);
#define GRID_BAR() do { PB_BEGIN(20) for (int rep_ = 0; rep_ < DUP_BAR; ++rep_) xcd_barrier(bar); PB_END(20, lds, (blockIdx.x == 0 && tid == 7 * 64)) } while (0)

    float* rowss = (float*)(ws + WS_ROWSS); float* lnst = (float*)(ws + WS_LNST);
    bf16_t* WIN = (bf16_t*)(ws + WS_WIN); bf16_t* WOUT = (bf16_t*)(ws + WS_WOUT); bf16_t* WKVQ = (bf16_t*)(ws + WS_WKVQ); bf16_t* WQ3 = (bf16_t*)(ws + WS_WQ3);
    bf16_t* WBO = (bf16_t*)(ws + WS_WBO); bf16_t* WG = (bf16_t*)(ws + WS_WG); bf16_t* WP = (bf16_t*)(ws + WS_WP);
    bf16_t* PB = (bf16_t*)(ws + WS_PB); bf16_t* HB0 = (bf16_t*)(ws + WS_HB0);
    bf16_t* UG = (bf16_t*)(ws + WS_UG); bf16_t* GV = (bf16_t*)(ws + WS_GV);
    bf16_t* KB = (bf16_t*)(ws + WS_K); bf16_t* VB = (bf16_t*)(ws + WS_V); bf16_t* QB = (bf16_t*)(ws + WS_Q); bf16_t* SGB = (bf16_t*)(ws + WS_SG);
    bf16_t* OGB = (bf16_t*)args.out;

    for (int rep0 = 0; rep0 < DUP_P0; ++rep0) {
        int lane_p0 = tid & 63; asm volatile("" : "+v"(lane_p0)); const int lane = lane_p0;
        LAS float* scr = (LAS float*)(lds + wave * 16384);
        const int gw = vcu * NWAVES + wave, NGW = G * NWAVES; int jbase = 0;
        for (int i = 0; i < 2; ++i) TJOB(args.a_w_in + (size_t)i * D_MODEL * 6144, D_MODEL, 6144, 6144, 1, 0, args.norm_g + i * D_MODEL, WIN + (size_t)i * 6144 * D_MODEL);
        for (int i = 0; i < 2; ++i) TJOB(args.a_w_out + (size_t)i * A_WIDTH * D_MODEL, A_WIDTH, D_MODEL, D_MODEL, 0, 0, (const float*)nullptr, WOUT + (size_t)i * D_MODEL * A_WIDTH);
        TJOB(args.w_kv, D_MODEL, 2048, 2048, 0, 0, args.kv_norm_g, WKVQ);
        TJOB(args.b_w_in, D_MODEL, 2048, 2048, 0, 0, args.norm_g + 2 * D_MODEL, WKVQ + (size_t)2048 * D_MODEL);
        TJOB(args.b_w_in + (size_t)D_MODEL * 2048, D_MODEL, 2048, 2048, 0, 0, args.norm_g + 3 * D_MODEL, WQ3);
        for (int i = 0; i < 2; ++i) TJOB(args.b_w_out + (size_t)i * D_MODEL * D_MODEL, D_MODEL, D_MODEL, D_MODEL, 0, 0, (const float*)nullptr, WBO + (size_t)i * D_MODEL * D_MODEL);
        for (int i = 0; i < 4; ++i) TJOB(args.ple_gate_w + (size_t)i * D_MODEL * D_MODEL, D_MODEL, D_MODEL, D_MODEL, 0, 0, (const float*)nullptr, WG + (size_t)i * D_MODEL * D_MODEL);
        for (int i = 0; i < 4; ++i) TJOB(args.ple_w + (size_t)i * PLE_DIM * D_MODEL, PLE_DIM, D_MODEL, D_MODEL, 0, 0, (const float*)nullptr, WP + (size_t)i * D_MODEL * PLE_DIM);
        for (int m = gw; m < M; m += 2 * NGW) {
            const int m2 = m + NGW;
            const f32x4* xr = (const f32x4*)(args.x + (size_t)m * D_MODEL) + 2 * lane; const f32x4* xr2 = (const f32x4*)(args.x + (size_t)m2 * D_MODEL) + 2 * lane;
            f32x4 va[4], vb[4];
#pragma unroll
            for (int j = 0; j < 2; ++j) { va[2 * j] = xr[128 * j]; va[2 * j + 1] = xr[128 * j + 1]; vb[2 * j] = xr2[128 * j]; vb[2 * j + 1] = xr2[128 * j + 1]; }
            float s = 0.f, s2 = 0.f;
#pragma unroll
            for (int j = 0; j < 4; ++j) { s += (va[j][0] * va[j][0] + va[j][1] * va[j][1]) + (va[j][2] * va[j][2] + va[j][3] * va[j][3]); s2 += (vb[j][0] * vb[j][0] + vb[j][1] * vb[j][1]) + (vb[j][2] * vb[j][2] + vb[j][3] * vb[j][3]); }
#pragma unroll
            for (int j = 0; j < 2; ++j) {
                u32x4 o; o.x = pk2(va[2 * j][0], va[2 * j][1]); o.y = pk2(va[2 * j][2], va[2 * j][3]); o.z = pk2(va[2 * j + 1][0], va[2 * j + 1][1]); o.w = pk2(va[2 * j + 1][2], va[2 * j + 1][3]);
                pg8::st16_wt(HB0 + (size_t)m * D_MODEL + 512 * j + 8 * lane, o);
                o.x = pk2(vb[2 * j][0], vb[2 * j][1]); o.y = pk2(vb[2 * j][2], vb[2 * j][3]); o.z = pk2(vb[2 * j + 1][0], vb[2 * j + 1][1]); o.w = pk2(vb[2 * j + 1][2], vb[2 * j + 1][3]);
                pg8::st16_wt(HB0 + (size_t)m2 * D_MODEL + 512 * j + 8 * lane, o); }
            s = wave_sum(s); s2 = wave_sum(s2);
            if (lane < 16) { rowss[(size_t)m * 16 + lane] = (lane == 0) ? s : 0.f; rowss[(size_t)m2 * 16 + lane] = (lane == 0) ? s2 : 0.f; }
        }
        convert_p(args.p, PB, vcu * 512 + tid, G * 512);
    }
    GRID_BAR();

    for (int L = 0; L < DEPTH; ++L) {
        bf16_t* Ebuf = (L < N_A) ? (bf16_t*)(ws + WS_EA) : (bf16_t*)(ws + WS_EB);
        bf16_t* HB1 = (L < N_A) ? (bf16_t*)(ws + WS_HB1A) : (bf16_t*)(ws + WS_HB1B);
        if (L < N_A) {
            { pg8::Gemm g{HB0, WIN + (size_t)L * 6144 * D_MODEL, M, 6144, D_MODEL}; pg8::StaticOrder S; S.init(M, 6144, G, bx);
              pg8::fill_rstd(lds, rowss, S, tid);
              pg8::EpiA1 E{UG, GV, lnst, (const LAS float*)(lds + RSTD_OFF)};
              for (int rep = 0; rep < DUP_A1; ++rep) pg8::gemm_phase<pg8::EpiA1, pg8::StaticOrder, true, true>(lds, g, S, E, (unsigned)(vcu & 7) * STAGGER_TICKS); }
            GRID_BAR();
            if (L > 0) convert_p(args.p + (size_t)L * M * PLE_DIM, PB, vcu * 512 + tid, G * 512);
            if (G == 256) for (int rep = 0; rep < DUP_MIX; ++rep)
                mix_phase(lds, vcu, args.a_w_s + (size_t)L * A_GROUPS * 128 * 128, args.a_b_s + (size_t)L * A_GROUPS * 128, args.a_ln_g + (size_t)L * A_WIDTH, args.a_ln_b + (size_t)L * A_WIDTH,
                          GV, UG, rep + 1 < DUP_MIX ? OGB : UG, rep + 1 < DUP_MIX ? (size_t)(16u * MiB - 1) : ~(size_t)0, lnst, tid);
            GRID_BAR();
            { pg8::Gemm g{UG, WOUT + (size_t)L * D_MODEL * A_WIDTH, M, D_MODEL, A_WIDTH}; pg8::StaticOrder S; S.init(M, D_MODEL, G, bx);
              pg8::EpiMix E{HB0, HB1, lds};
              for (int rep = 0; rep < DUP_MIXG; ++rep) pg8::gemm_phase<pg8::EpiMix, pg8::StaticOrder, true, true>(lds, g, S, E); }
        } else {
            const int j = L - N_A;
            { pg8::Gemm g{HB0, j == 0 ? WKVQ : WQ3, M, j == 0 ? 4096 : 2048, D_MODEL}; pg8::StaticOrder S; S.init(M, g.N, G, bx);
              pg8::fill_rstd(lds, rowss, S, tid);
              pg8::EpiKVQ E{KB, VB, QB, SGB, (const LAS float*)(lds + RSTD_OFF), j == 0 ? 0 : 2};
              for (int rep = 0; rep < DUP_KVQ; ++rep) pg8::gemm_phase<pg8::EpiKVQ, pg8::StaticOrder, true, true>(lds, g, S, E, (unsigned)(vcu & 7) * STAGGER_TICKS); }
            GRID_BAR();
            convert_p(args.p + (size_t)L * M * PLE_DIM, PB, vcu * 512 + tid, G * 512);
            { const int xg = vcu >> 5, l = vcu & 31, bh1 = 8 * xg + (l >> 3), bh2 = bh1 + 4, q1 = l & 7, q2 = 7 - q1;
              if (G == 256) {
                  for (int rep = 1; rep < DUP_ATTN; ++rep) {
                  attn_unit<DUP_LITE>(lds, bh1 >> 3, bh1 & 7, q1, QB, KB, VB, SGB, OGB + (size_t)M * D_MODEL, tid);
                  attn_unit<DUP_LITE>(lds, bh2 >> 3, bh2 & 7, q2, QB, KB, VB, SGB, OGB + (size_t)M * D_MODEL, tid); }
                  attn_unit(lds, bh1 >> 3, bh1 & 7, q1, QB, KB, VB, SGB, OGB, tid);
                  attn_unit(lds, bh2 >> 3, bh2 & 7, q2, QB, KB, VB, SGB, OGB, tid);
              } }
            GRID_BAR();
            { pg8::Gemm g{OGB, WBO + (size_t)j * D_MODEL * D_MODEL, M, D_MODEL, D_MODEL}; pg8::StaticOrder S; S.init(M, D_MODEL, G, bx);
              pg8::EpiMix E{HB0, HB1, lds};
              for (int rep = 0; rep < DUP_MIXG; ++rep) pg8::gemm_phase<pg8::EpiMix, pg8::StaticOrder, true, true>(lds, g, S, E); }
        }
        { pg8::Gemm g{PB, WP + (size_t)L * D_MODEL * PLE_DIM, M, D_MODEL, PLE_DIM}; pg8::StaticOrder S; S.init(M, D_MODEL, G, bx);
          pg8::EpiE E{Ebuf};
          for (int rep = 0; rep < DUP_E; ++rep) pg8::gemm_phase<pg8::EpiE, pg8::StaticOrder, true, true>(lds, g, S, E); }
        GRID_BAR();
        { pg8::Gemm g{HB1, WG + (size_t)L * D_MODEL * D_MODEL, M, D_MODEL, D_MODEL}; pg8::StaticOrder S; S.init(M, D_MODEL, G, bx);
          pg8::EpiPle E{HB1, Ebuf, HB0, rowss, lds};
          for (int rep = 0; rep < DUP_PLE; ++rep) pg8::gemm_phase<pg8::EpiPle, pg8::StaticOrder, true, true>(lds, g, S, E); }
        GRID_BAR();
    }
    {
        int lane_fn = tid & 63; asm volatile("" : "+v"(lane_fn)); const int lane = lane_fn;
        const int gw = vcu * NWAVES + wave, NGW = G * NWAVES;
        f32x4 gv[4];
#pragma unroll
        for (int j = 0; j < 4; ++j) gv[j] = *((const f32x4*)args.final_g + lane + 64 * j);
        for (int m = gw; m < M; m += NGW) {
            const u32x2* hr = (const u32x2*)(HB0 + (size_t)m * D_MODEL) + lane; f32x4* orow = (f32x4*)(args.out + (size_t)m * D_MODEL) + lane; f32x4 v[4]; float s = 0.f;
#pragma unroll
            for (int j = 0; j < 4; ++j) { const u32x2 w = hr[64 * j]; v[j] = (f32x4){bflo(w.x), bfhi(w.x), bflo(w.y), bfhi(w.y)}; s += (v[j][0] * v[j][0] + v[j][1] * v[j][1]) + (v[j][2] * v[j][2] + v[j][3] * v[j][3]); }
            const float rstd = 1.0f / sqrtf(wave_sum(s) * (1.0f / D_MODEL) + EPS);
#pragma unroll
            for (int j = 0; j < 4; ++j) orow[64 * j] = v[j] * rstd * gv[j];
        }
    }
    if (PROBE_ID != 0 && blockIdx.x == 0) {
        __syncthreads();
        if (tid == 7 * 64) { const unsigned w = *PB_WORD(lds); const unsigned long long t0 = __builtin_amdgcn_s_memrealtime(); while ((unsigned)(__builtin_amdgcn_s_memrealtime() - t0) < w) __builtin_amdgcn_s_sleep(8); }
    }
}

extern "C" void kernel_launch(void* const* d_in, const int* in_sizes, int n_in, void* d_out, int out_size, void* d_ws, size_t ws_size, hipStream_t stream) {
    static int grid = 0;
    if (grid == 0) {
        if (n_in != 16 || in_sizes[0] != M * D_MODEL || out_size != M * D_MODEL || ws_size < WS_END) { fprintf(stderr, "kernel_launch: unexpected shapes (n_in %d, ws %zu); nothing launched\n", n_in, ws_size); grid = -1; return; }
        int dev = 0, cus = 0, per_cu = 0;
        if (hipGetDevice(&dev) != hipSuccess || hipDeviceGetAttribute(&cus, hipDeviceAttributeMultiprocessorCount, dev) != hipSuccess) { grid = -1; return; }
        if (hipFuncSetAttribute((const void*)yoco_fwd, hipFuncAttributeMaxDynamicSharedMemorySize, LDS_BYTES) != hipSuccess) { fprintf(stderr, "kernel_launch: hipFuncSetAttribute failed\n"); grid = -1; return; }
        if (hipOccupancyMaxActiveBlocksPerMultiprocessor(&per_cu, (const void*)yoco_fwd, NWAVES * 64, LDS_BYTES) != hipSuccess || per_cu < 1) { fprintf(stderr, "kernel_launch: occupancy query says %d blocks per CU\n", per_cu); per_cu = 1; }
        (void)hipGetLastError();
        grid = cus * 1;
    }
    if (grid < 0) return;
    (void)hipMemsetAsync((char*)d_ws + WS_CTL, 0, CTL_ZERO_BYTES, stream);
    Args a{};
    a.x = (const float*)d_in[0]; a.p = (const float*)d_in[1]; a.norm_g = (const float*)d_in[2]; a.a_w_in = (const float*)d_in[3]; a.a_ln_g = (const float*)d_in[4]; a.a_ln_b = (const float*)d_in[5];
    a.a_w_s = (const float*)d_in[6]; a.a_b_s = (const float*)d_in[7]; a.a_w_out = (const float*)d_in[8]; a.kv_norm_g = (const float*)d_in[9]; a.w_kv = (const float*)d_in[10]; a.b_w_in = (const float*)d_in[11];
    a.b_w_out = (const float*)d_in[12]; a.ple_w = (const float*)d_in[13]; a.ple_gate_w = (const float*)d_in[14]; a.final_g = (const float*)d_in[15];
    a.out = (float*)d_out; a.ws = (unsigned char*)d_ws;
    void* kargs[] = {&a};
    hipError_t e = hipLaunchCooperativeKernel((const void*)yoco_fwd, dim3(grid), dim3(NWAVES * 64), kargs, LDS_BYTES, stream);
    if (e != hipSuccess) fprintf(stderr, "kernel_launch: cooperative launch failed: %s (grid %d)\n", hipGetErrorString(e), grid);
}
```
